# Optimizing an MI355X kernel written in HIP

```python
import math
import jax, jax.numpy as jnp
from jax import lax
import numpy as np

D_MODEL = 2048
BATCH = 1
SEQ = 8192
DEPTH = 4
DEC_BATCH = 1
DEC_SEQ = 16384
PAST_LEN = 128

HEAD_DIM = 128
N_HEADS = D_MODEL // HEAD_DIM
H_RET = N_HEADS // 2
H_ATT = N_HEADS - H_RET
H_KV = max(1, H_ATT // 4)
D_RET = H_RET * HEAD_DIM
D_ATT = H_ATT * HEAD_DIM
D_KV = H_KV * HEAD_DIM
D_MIX = D_RET + D_ATT
D_IN = 4 * D_RET + D_ATT + 2 * D_KV
D_FF = -(-8 * D_MODEL // (3 * 256)) * 256
CHUNK = 128
BLOCK = 128
WINDOW = 128
N_BUCKETS = 32
MAX_DISTANCE = 128
ROPE_BASE = 10000.0
ALPHA = (2 * DEPTH) ** 0.25
BETA = (8 * DEPTH) ** -0.25
LN_EPS = 1e-5
GN_EPS = 1e-5
NEG = -1e30

kernel_name = 'hymba_retention_swa_deepnorm_encoder'


def layer_norm(x, w, b):
    xf = x.astype(jnp.float32)
    mu = xf.mean(-1, keepdims=True)
    var = jnp.square(xf - mu).mean(-1, keepdims=True)
    return ((xf - mu) * lax.rsqrt(var + LN_EPS) * w.astype(jnp.float32) + b.astype(jnp.float32)).astype(x.dtype)


def rotary(x, pos):
    half = HEAD_DIM // 2
    inv = ROPE_BASE ** (-jnp.arange(half, dtype=jnp.float32) / half)
    ang = pos.astype(jnp.float32)[:, None] * inv[None, :]
    cos = jnp.cos(ang)[None, :, None, :]
    sin = jnp.sin(ang)[None, :, None, :]
    x1, x2 = x[..., :half], x[..., half:]
    return jnp.concatenate([x1 * cos - x2 * sin, x1 * sin + x2 * cos], axis=-1)


def retention_direction(q, k, v, log_gamma, strict):
    B, S, H, d = q.shape
    nc = S // CHUNK
    qc = q.reshape(B, nc, CHUNK, H, d)
    kc = k.reshape(B, nc, CHUNK, H, d)
    vc = v.reshape(B, nc, CHUNK, H, d)
    idx = jnp.arange(CHUNK, dtype=jnp.float32)
    diff = idx[:, None] - idx[None, :]
    mask = (diff > 0) if strict else (diff >= 0)
    decay = jnp.where(mask[None], jnp.exp(log_gamma[:, None, None] * jnp.maximum(diff, 0.0)[None]), 0.0)
    inner = jnp.einsum('bnihd,bnjhd->bnhij', qc, kc) * decay[None, None]
    o_inner = jnp.einsum('bnhij,bnjhd->bnihd', inner, vc)
    zeta = jnp.exp(log_gamma[None, :] * (CHUNK - 1 - idx)[:, None])
    kv = jnp.einsum('bnjhd,bnjhe->nbhde', kc * zeta[None, None, :, :, None], vc)
    g_chunk = jnp.exp(log_gamma * CHUNK)[None, :, None, None]

    def step(state, kv_c):
        return g_chunk * state + kv_c, state

    _, prev = lax.scan(step, jnp.zeros_like(kv[0]), kv)
    xi = jnp.exp(log_gamma[None, :] * (idx + 1.0)[:, None])
    o_cross = jnp.einsum('bnihd,nbhde->bnihe', qc, prev) * xi[None, None, :, :, None]
    return (o_inner + o_cross).reshape(B, S, H, d)


def t5_bucket(rel):
    nb = N_BUCKETS // 2
    ret = (rel > 0).astype(jnp.int32) * nb
    n = jnp.abs(rel)
    max_exact = nb // 2
    large = max_exact + (jnp.log(jnp.maximum(n, 1).astype(jnp.float32) / max_exact)
                         / math.log(MAX_DISTANCE / max_exact) * (nb - max_exact)).astype(jnp.int32)
    large = jnp.minimum(large, nb - 1)
    return ret + jnp.where(n < max_exact, n, large)


def window_attention(q, k, v, rel_bias, sink):
    B, S = q.shape[0], q.shape[1]
    nb = S // BLOCK
    rep = H_ATT // H_KV
    qb = q.reshape(B, nb, BLOCK, H_KV, rep, HEAD_DIM)
    pad = ((0, 0), (BLOCK, BLOCK), (0, 0), (0, 0))

    def band(t):
        tb = jnp.pad(t, pad).reshape(B, nb + 2, BLOCK, H_KV, HEAD_DIM)
        return jnp.concatenate([tb[:, :-2], tb[:, 1:-1], tb[:, 2:]], axis=2)

    kb, vb = band(k), band(v)
    qi = jnp.arange(BLOCK, dtype=jnp.int32)
    kj = jnp.arange(3 * BLOCK, dtype=jnp.int32) - BLOCK
    rel = kj[None, :] - qi[:, None]
    in_window = jnp.abs(rel) <= WINDOW
    bias = rel_bias[t5_bucket(rel)].astype(jnp.float32)
    bias = bias.transpose(2, 0, 1).reshape(H_KV, rep, BLOCK, 3 * BLOCK)
    key_pos = jnp.arange(nb, dtype=jnp.int32)[:, None] * BLOCK + kj[None, :]
    valid = (key_pos >= 0) & (key_pos < S)
    mask = in_window[None] & valid[:, None, :]
    s = jnp.einsum('bnqgrd,bnkgd->bngrqk', qb, kb).astype(jnp.float32) * (HEAD_DIM ** -0.5) + bias[None, None]
    s = jnp.where(mask[None, :, None, None], s, NEG)
    sink_l = sink.astype(jnp.float32).reshape(H_KV, rep)[None, None, :, :, None, None]
    m = jnp.maximum(s.max(-1, keepdims=True), sink_l)
    p = jnp.exp(s - m)
    p = p / (p.sum(-1, keepdims=True) + jnp.exp(sink_l - m))
    o = jnp.einsum('bngrqk,bnkgd->bnqgrd', p.astype(v.dtype), vb)
    return o.reshape(B, S, D_ATT)


def trunk(x, w_in, w_out, ret_decay_fwd, ret_decay_bwd, ret_gn_w, attn_sink, rel_bias,
          ln1_w, ln1_b, w_ffn_in, w_ffn_out, ln2_w, ln2_b):
    B, S, _ = x.shape
    pos = jnp.arange(S, dtype=jnp.int32)
    splits = [D_RET, 2 * D_RET, 3 * D_RET, 4 * D_RET, 4 * D_RET + D_ATT, 4 * D_RET + D_ATT + D_KV]
    for l in range(DEPTH):
        h = jnp.einsum('bsd,de->bse', x, w_in[l])
        rq, rk, rv, rg, aq, ak, av = jnp.split(h, splits, axis=-1)
        f32 = jnp.float32
        q = rotary(rq.astype(f32).reshape(B, S, H_RET, HEAD_DIM), pos)
        k = rotary(rk.astype(f32).reshape(B, S, H_RET, HEAD_DIM), pos) * (HEAD_DIM ** -0.5)
        v = rv.astype(f32).reshape(B, S, H_RET, HEAD_DIM)
        lg_f = jax.nn.log_sigmoid(ret_decay_fwd[l].astype(f32))
        lg_b = jax.nn.log_sigmoid(ret_decay_bwd[l].astype(f32))
        o_f = retention_direction(q, k, v, lg_f, False)
        o_b = jnp.flip(retention_direction(jnp.flip(q, 1), jnp.flip(k, 1), jnp.flip(v, 1), lg_b, True), 1)
        o = o_f + o_b
        mu = o.mean(-1, keepdims=True)
        var = jnp.square(o - mu).mean(-1, keepdims=True)
        o = ((o - mu) * lax.rsqrt(var + GN_EPS)).reshape(B, S, D_RET) * ret_gn_w[l].astype(f32)
        ret_out = (jax.nn.silu(rg.astype(f32)) * o).astype(x.dtype)
        att_out = window_attention(aq.reshape(B, S, H_ATT, HEAD_DIM),
                                   ak.reshape(B, S, H_KV, HEAD_DIM),
                                   av.reshape(B, S, H_KV, HEAD_DIM),
                                   rel_bias, attn_sink[l])
        mix = jnp.einsum('bse,ed->bsd', jnp.concatenate([ret_out, att_out], axis=-1), w_out[l])
        x = layer_norm(ALPHA * x + mix, ln1_w[l], ln1_b[l])
        gu = jnp.einsum('bsd,df->bsf', x, w_ffn_in[l])
        gate, up = jnp.split(gu, [D_FF], axis=-1)
        f = jnp.einsum('bsf,fd->bsd', jax.nn.silu(gate) * up, w_ffn_out[l])
        x = layer_norm(ALPHA * x + f, ln2_w[l], ln2_b[l])
    return x


def setup_inputs(seed: int = 0) -> dict:
    key = jax.random.key(seed)
    ks = jax.random.split(key, 16)
    x_prompt = jax.random.normal(ks[0], (BATCH, SEQ, D_MODEL), jnp.float32)
    x_sample = jax.random.normal(ks[1], (DEC_BATCH, DEC_SEQ, D_MODEL), jnp.float32)
    w_in = jax.random.normal(ks[2], (DEPTH, D_MODEL, D_IN), jnp.float32) * (D_MODEL ** -0.5)
    col_scale = jnp.ones((D_IN,), jnp.float32)
    col_scale = col_scale.at[2 * D_RET:3 * D_RET].set(BETA)
    col_scale = col_scale.at[4 * D_RET + D_ATT + D_KV:].set(BETA)
    w_in = w_in * col_scale
    w_out = jax.random.normal(ks[3], (DEPTH, D_MIX, D_MODEL), jnp.float32) * (D_MIX ** -0.5) * BETA
    base = jnp.log(2.0 ** (5.0 + jnp.arange(H_RET, dtype=jnp.float32)) - 1.0)
    ret_decay_fwd = base[None, :] + 0.1 * jax.random.normal(ks[4], (DEPTH, H_RET), jnp.float32)
    ret_decay_bwd = base[None, :] + 0.1 * jax.random.normal(ks[5], (DEPTH, H_RET), jnp.float32)
    ret_gn_w = 1.0 + 0.02 * jax.random.normal(ks[6], (DEPTH, D_RET), jnp.float32)
    attn_sink = 0.5 * jax.random.normal(ks[7], (DEPTH, H_ATT), jnp.float32)
    rel_bias = 0.5 * jax.random.normal(ks[8], (N_BUCKETS, H_ATT), jnp.float32)
    ln1_w = 1.0 + 0.02 * jax.random.normal(ks[9], (DEPTH, D_MODEL), jnp.float32)
    ln1_b = 0.02 * jax.random.normal(ks[10], (DEPTH, D_MODEL), jnp.float32)
    w_ffn_in = jax.random.normal(ks[11], (DEPTH, D_MODEL, 2 * D_FF), jnp.float32) * (D_MODEL ** -0.5) * BETA
    w_ffn_out = jax.random.normal(ks[12], (DEPTH, D_FF, D_MODEL), jnp.float32) * (D_FF ** -0.5) * BETA
    ln2_w = 1.0 + 0.02 * jax.random.normal(ks[13], (DEPTH, D_MODEL), jnp.float32)
    ln2_b = 0.02 * jax.random.normal(ks[14], (DEPTH, D_MODEL), jnp.float32)
    return {'x_prompt': x_prompt, 'x_sample': x_sample, 'w_in': w_in, 'w_out': w_out,
            'ret_decay_fwd': ret_decay_fwd, 'ret_decay_bwd': ret_decay_bwd, 'ret_gn_w': ret_gn_w,
            'attn_sink': attn_sink, 'rel_bias': rel_bias, 'ln1_w': ln1_w, 'ln1_b': ln1_b,
            'w_ffn_in': w_ffn_in, 'w_ffn_out': w_ffn_out, 'ln2_w': ln2_w, 'ln2_b': ln2_b}


def reference(x_prompt, x_sample, w_in, w_out, ret_decay_fwd, ret_decay_bwd, ret_gn_w,
              attn_sink, rel_bias, ln1_w, ln1_b, w_ffn_in, w_ffn_out, ln2_w, ln2_b):
    y_prompt = trunk(x_prompt, w_in, w_out, ret_decay_fwd, ret_decay_bwd, ret_gn_w, attn_sink, rel_bias,
                     ln1_w, ln1_b, w_ffn_in, w_ffn_out, ln2_w, ln2_b)
    y_sample = trunk(x_sample, w_in, w_out, ret_decay_fwd, ret_decay_bwd, ret_gn_w, attn_sink, rel_bias,
                     ln1_w, ln1_b, w_ffn_in, w_ffn_out, ln2_w, ln2_b)
    return (y_prompt, y_sample)
```

```cpp
#include <hip/hip_runtime.h>
#include <hip/hip_cooperative_groups.h>
#include <cstdio>
#include <cstdint>
namespace cg = cooperative_groups;

#ifndef MIX_REP
#define MIX_REP 1
#endif
#ifndef ONE_LAUNCH
#define ONE_LAUNCH 1
#endif

#define LAS __attribute__((address_space(3)))
typedef unsigned short bf16_t;
typedef short bf16x8 __attribute__((ext_vector_type(8)));
typedef short s16x4 __attribute__((ext_vector_type(4)));
typedef float f32x4 __attribute__((ext_vector_type(4)));
typedef float f32x2 __attribute__((ext_vector_type(2)));
typedef unsigned u32x4 __attribute__((ext_vector_type(4)));
typedef unsigned u32x2 __attribute__((ext_vector_type(2)));

constexpr int S0 = 8192, S1 = 16384, MTOK = S0 + S1;
constexpr int DM = 2048, DIN = 5632, DFF = 5632, DFF2 = 11264, DEPTH = 4;
constexpr int C_RQ = 0, C_RK = 1024, C_RV = 2048, C_RG = 3072, C_AQ = 4096, C_AK = 5120, C_AV = 5376;
constexpr int NCHUNK = MTOK / 128;
constexpr float ALPHA = 1.681792830507429f;
constexpr float LOG2E = 1.4426950408889634f;

constexpr size_t SZ_WIN = (size_t)DIN * DM * 2, SZ_WOUT = (size_t)DM * DM * 2, SZ_WFI = (size_t)DFF2 * DM * 2, SZ_WFO = (size_t)DM * DFF * 2;
constexpr size_t WS_WIN = 0;
constexpr size_t WS_WOUT = WS_WIN + DEPTH * SZ_WIN;
constexpr size_t WS_WFI = WS_WOUT + DEPTH * SZ_WOUT;
constexpr size_t WS_WFO = WS_WFI + DEPTH * SZ_WFI;
constexpr size_t WS_XN = WS_WFO + DEPTH * SZ_WFO;
constexpr size_t WS_H = WS_XN + (size_t)MTOK * DM * 2;
constexpr size_t WS_MIX = WS_H + (size_t)MTOK * DIN * 2;
constexpr size_t WS_Y = WS_MIX + (size_t)MTOK * DM * 2;
constexpr size_t WS_YH = WS_Y + (size_t)MTOK * DM * 2;
constexpr size_t WS_PREV = WS_Y + (size_t)MTOK * DM * 4;
constexpr size_t WS_ROT = WS_PREV + (size_t)NCHUNK * 8 * 2 * 16384 * 2;
constexpr size_t WS_BIAS = WS_ROT + (size_t)16384 * 64 * 8;
constexpr size_t WS_LG = WS_BIAS + 12288;
constexpr size_t WS_STATS = WS_BIAS + 16384;
constexpr size_t WS_BAR = WS_STATS + (size_t)MTOK * 8;
constexpr size_t WS_YL = WS_BAR + 16384;
constexpr size_t WS_END = WS_YL + (size_t)MTOK * DM * 2;

constexpr int LDS_BYTES = 133120;

__device__ __forceinline__ unsigned cvt_pk_bf16(float lo, float hi) { unsigned r; asm volatile("v_cvt_pk_bf16_f32 %0, %1, %2" : "=v"(r) : "v"(lo), "v"(hi)); return r; }
__device__ __forceinline__ float bf_lo(unsigned w) { return __uint_as_float(w << 16); }
__device__ __forceinline__ float bf_hi(unsigned w) { return __uint_as_float(w & 0xffff0000u); }
__device__ __forceinline__ float fast_exp2(float x) { return __builtin_amdgcn_exp2f(x); }
__device__ __forceinline__ float fast_rcp(float x) { return __builtin_amdgcn_rcpf(x); }
__device__ __forceinline__ float silu_f(float g) { return g * fast_rcp(1.0f + fast_exp2(-g * LOG2E)); }
__device__ __forceinline__ float log_sigmoid_f(float x) { return x >= 0.f ? -log1pf(expf(-x)) : x - log1pf(expf(x)); }
#define LDS_WAIT() asm volatile("s_waitcnt lgkmcnt(0)" ::: "memory")
__device__ __forceinline__ u32x4 widen16(u32x2 a, u32x2 b) {
    const auto r0 = __builtin_amdgcn_permlane16_swap(a.x, b.x, false, false);
    const auto r1 = __builtin_amdgcn_permlane16_swap(a.y, b.y, false, false);
    u32x4 o; o.x = r0[0]; o.y = r1[0]; o.z = r0[1]; o.w = r1[1]; return o;
}
__device__ __forceinline__ void unwiden16(u32x4 v, u32x2& a, u32x2& b) {
    const auto r0 = __builtin_amdgcn_permlane16_swap(v.x, v.z, false, false);
    const auto r1 = __builtin_amdgcn_permlane16_swap(v.y, v.w, false, false);
    a.x = r0[0]; a.y = r1[0]; b.x = r0[1]; b.y = r1[1];
}
__device__ __forceinline__ f32x4 hl_sum(u32x2 h, u32x2 l) { return (f32x4){bf_lo(h.x) + bf_lo(l.x), bf_hi(h.x) + bf_hi(l.x), bf_lo(h.y) + bf_lo(l.y), bf_hi(h.y) + bf_hi(l.y)}; }
__device__ __forceinline__ void hl_split(f32x4 o, u32x2& h, u32x2& l) {
    h.x = cvt_pk_bf16(o.x, o.y); h.y = cvt_pk_bf16(o.z, o.w);
    l.x = cvt_pk_bf16(o.x - bf_lo(h.x), o.y - bf_hi(h.x)); l.y = cvt_pk_bf16(o.z - bf_lo(h.y), o.w - bf_hi(h.y));
}

#define GAS __attribute__((address_space(1)))
#define GLD(T, p) (*(const GAS T*)(p))
#define GST(T, p) (*(GAS T*)(p))

namespace pg8 {
constexpr int BM = 256, BK = 64, HALF = 128, HTB = HALF * BK * 2, STAGE_BYTES = 8 * HTB, NXCD = 8, WGM = 8;
__host__ __device__ __forceinline__ int lds_byte(int r, int c) { const int st = (r >> 4) * 2 + (c >> 5), rr = r & 15, cc = c & 31, ob = rr * 64 + cc * 2; return st * 1024 + (ob ^ (((ob >> 9) & 1) << 5)); }
__host__ __device__ __forceinline__ void stage_rc(int b, int& R, int& C) { const int st = b / 1024, sb = b % 1024, swz = sb ^ (((sb >> 9) & 1) << 5); R = (st >> 1) * 16 + swz / 64; C = (st & 1) * 32 + (swz % 64) / 2; }
struct Unit { int pm, pn; };
struct Gemm { const bf16_t* A; const bf16_t* Bt; int M, N, K; };
struct StaticOrder {
    int nM, nN, nwg, G, c, wgm;
    __device__ void init(int M, int N, int G_, int c_, int wgm_ = WGM) { nM = M / BM; nN = N / BM; nwg = nM * nN; G = G_; c = c_; wgm = wgm_; }
    __device__ bool next(int i, Unit& u) const {
        const long L = (long)i * G + c; if (L >= nwg) return false;
        int wgid = (int)L; { const int q = nwg / NXCD, r = nwg % NXCD, xcd = wgid % NXCD, off = wgid / NXCD; wgid = (xcd < r ? xcd * (q + 1) : r * (q + 1) + (xcd - r) * q) + off; }
        const int nig = wgm * nN, gid = wgid / nig, fm = gid * wgm, gsz = (nM - fm) < wgm ? (nM - fm) : wgm;
        u.pm = fm + ((wgid % nig) % gsz); u.pn = (wgid % nig) / gsz; return true;
    }
};

template <class Epi>
__device__ __forceinline__ void gemm_phase(LAS unsigned char* lds, const Gemm g, const StaticOrder& S, const Epi& E, const int tid) {
    const int wid = __builtin_amdgcn_readfirstlane(tid >> 6), lane = tid & 63, wr = wid >> 2, wc = wid & 3, fr = lane & 15, fq = lane >> 4;
    const int K = g.K, nt = K / BK;
    unsigned voffA[2];
#pragma unroll
    for (int i = 0; i < 2; ++i) { int R, C; stage_rc(tid * 16 + i * 8192, R, C); voffA[i] = (unsigned)(R * K + C) * 2u; }
    const size_t kstep = (size_t)(BK * 2);
    const size_t hstep = (size_t)HALF * K * 2;
    const size_t tstep = 2 * hstep;
    const unsigned ldsw = (unsigned)wid * 1024u;
    const int aoff = lds_byte(wr * 64 + fr, fq * 8), boff = lds_byte(wc * 32 + fr, fq * 8);
#define PG8_SA(b, h) (((b) * 2 + (h)) * HTB)
#define PG8_SB(b, h) ((4 + (b) * 2 + (h)) * HTB)
#define PG8_STAGE(bufoff, gbase) do { _Pragma("unroll") for (int _i = 0; _i < 2; ++_i) \
        __builtin_amdgcn_global_load_lds((const unsigned*)((const char*)(gbase) + voffA[_i]), (LAS unsigned*)(lds + (bufoff) + ldsw + _i * 8192), 16, 0, 0); } while (0)
#define PG8_LDA(dst, b, h) do { _Pragma("unroll") for (int m = 0; m < 4; ++m) _Pragma("unroll") for (int k = 0; k < 2; ++k) dst[m][k] = *(const LAS bf16x8*)(lds + PG8_SA(b, h) + aoff + m * 2048 + k * 1024); } while (0)
#define PG8_LDB(dst, b, h) do { _Pragma("unroll") for (int n = 0; n < 2; ++n) _Pragma("unroll") for (int k = 0; k < 2; ++k) dst[n][k] = *(const LAS bf16x8*)(lds + PG8_SB(b, h) + boff + n * 2048 + k * 1024); } while (0)
#define PG8_MMA(ai, bj, At, Bt) do { __builtin_amdgcn_s_setprio(1); _Pragma("unroll") for (int m = 0; m < 4; ++m) _Pragma("unroll") for (int n = 0; n < 2; ++n) _Pragma("unroll") for (int k = 0; k < 2; ++k) \
        acc[ai][bj][m][n] = __builtin_amdgcn_mfma_f32_16x16x32_bf16(Bt[n][k], At[m][k], acc[ai][bj][m][n], 0, 0, 0); __builtin_amdgcn_s_setprio(0); } while (0)
#define PG8_WAIT_V(n) asm volatile("s_waitcnt vmcnt(" #n ")" ::: "memory")
#define PG8_WAIT_L(n) asm volatile("s_waitcnt lgkmcnt(" #n ")" ::: "memory")
#define PG8_BAR __builtin_amdgcn_s_barrier()
#define PG8_SCHED __builtin_amdgcn_sched_barrier(0)
    Unit cur, nxt; int ui = 0;
    if (!S.next(0, cur)) return;
    f32x4 acc[2][2][4][2];
#pragma unroll
    for (int a = 0; a < 2; ++a)
#pragma unroll
        for (int b = 0; b < 2; ++b)
#pragma unroll
            for (int m = 0; m < 4; ++m)
#pragma unroll
                for (int n = 0; n < 2; ++n) acc[a][b][m][n] = (f32x4){0.f, 0.f, 0.f, 0.f};
    bf16x8 At[4][2], B0[2][2], B1[2][2];
    const char* cA = (const char*)g.A + (size_t)cur.pm * tstep; const char* cB = (const char*)g.Bt + (size_t)cur.pn * tstep;
    PG8_STAGE(PG8_SB(0, 0), cB); PG8_STAGE(PG8_SB(0, 1), cB + hstep); PG8_STAGE(PG8_SA(0, 0), cA); PG8_STAGE(PG8_SA(0, 1), cA + hstep);
    if (wr == 1) PG8_BAR;
    PG8_WAIT_V(2); PG8_BAR;
    PG8_STAGE(PG8_SB(1, 0), cB + kstep); PG8_STAGE(PG8_SA(1, 0), cA + kstep); PG8_STAGE(PG8_SB(1, 1), cB + hstep + kstep);
    PG8_WAIT_V(6); PG8_BAR;
    for (;;) {
        const bool has_next = S.next(ui + 1, nxt);
        const char* nA = has_next ? (const char*)g.A + (size_t)nxt.pm * tstep : cA; const char* nB = has_next ? (const char*)g.Bt + (size_t)nxt.pn * tstep : cB;
        for (int t = 0; t < nt; t += 2) {
            const bool last = (t == nt - 2);
            const char* a1 = cA + (size_t)(t + 1) * kstep;
            const char* a2 = last ? nA : cA + (size_t)(t + 2) * kstep; const char* b2 = last ? nB : cB + (size_t)(t + 2) * kstep;
            const char* a3 = a2 + kstep; const char* b3 = b2 + kstep;
            PG8_LDB(B0, 0, 0); PG8_LDB(B1, 0, 1); PG8_SCHED; PG8_LDA(At, 0, 0); PG8_STAGE(PG8_SA(1, 1), a1 + hstep);
            PG8_WAIT_V(8); PG8_WAIT_L(0); PG8_BAR; PG8_MMA(0, 0, At, B0); PG8_MMA(0, 1, At, B1); PG8_BAR; PG8_SCHED;
            PG8_LDA(At, 0, 1); PG8_STAGE(PG8_SB(0, 0), b2); PG8_STAGE(PG8_SB(0, 1), b2 + hstep); PG8_STAGE(PG8_SA(0, 0), a2);
            PG8_WAIT_V(8); PG8_WAIT_L(0); PG8_BAR; PG8_MMA(1, 0, At, B0); PG8_MMA(1, 1, At, B1); PG8_BAR; PG8_SCHED;
            PG8_LDB(B0, 1, 0); PG8_LDB(B1, 1, 1); PG8_SCHED; PG8_LDA(At, 1, 0); PG8_STAGE(PG8_SA(0, 1), a2 + hstep);
            PG8_WAIT_V(8); PG8_WAIT_L(0); PG8_BAR; PG8_MMA(0, 0, At, B0); PG8_MMA(0, 1, At, B1); PG8_BAR; PG8_SCHED;
            PG8_LDA(At, 1, 1); PG8_STAGE(PG8_SB(1, 0), b3); PG8_STAGE(PG8_SB(1, 1), b3 + hstep); PG8_STAGE(PG8_SA(1, 0), a3);
            PG8_WAIT_V(8); PG8_WAIT_L(0); PG8_BAR; PG8_MMA(1, 0, At, B0); PG8_MMA(1, 1, At, B1); PG8_BAR; PG8_SCHED;
        }
        if (wr == 0) PG8_BAR;
        E(acc, cur, wr, wc, fr, fq);
        if (!has_next) break;
#pragma unroll
        for (int a = 0; a < 2; ++a)
#pragma unroll
            for (int b = 0; b < 2; ++b)
#pragma unroll
                for (int m = 0; m < 4; ++m)
#pragma unroll
                    for (int n = 0; n < 2; ++n) acc[a][b][m][n] = (f32x4){0.f, 0.f, 0.f, 0.f};
        cur = nxt; cA = nA; cB = nB; ++ui;
        if (wr == 1) PG8_BAR;
    }
    PG8_WAIT_V(0);
    PG8_BAR;
#undef PG8_SA
#undef PG8_SB
#undef PG8_STAGE
#undef PG8_LDA
#undef PG8_LDB
#undef PG8_MMA
#undef PG8_WAIT_V
#undef PG8_WAIT_L
#undef PG8_BAR
#undef PG8_SCHED
}
}

struct EpiH {
    bf16_t* H; const float* rot;
    __device__ __forceinline__ void operator()(const f32x4 (&acc)[2][2][4][2], const pg8::Unit& u, int wr, int wc, int fr, int fq) const {
        asm volatile("" : "+v"(fr), "+v"(fq));
        const int rowt = u.pm * 256 + wr * 64 + fr;
        const int seq0 = (u.pm >= S0 / 256) ? S0 : 0;
        const bool dorot = u.pn < 8;
        const float ksc = (u.pn >= 4 && u.pn < 8) ? 0.08838834764831845f : 1.0f;
        const int cb = u.pn * 256 + 16 * wc + 4 * fq;
#pragma unroll
        for (int ai = 0; ai < 2; ++ai)
#pragma unroll
            for (int m = 0; m < 4; ++m) {
                const int row = rowt + ai * 128 + m * 16;
                f32x4 c4 = {1.f, 1.f, 1.f, 1.f}, s4 = {0.f, 0.f, 0.f, 0.f};
                if (dorot) { const GAS f32x4* rp = (const GAS f32x4*)(rot + ((size_t)(row - seq0) * 64 + 16 * wc + 4 * fq) * 2); const f32x4 a = rp[0], b = rp[1];
                    c4 = (f32x4){a.x, a.z, b.x, b.z}; s4 = (f32x4){a.y, a.w, b.y, b.w}; }
#pragma unroll
                for (int bj = 0; bj < 2; ++bj) {
                    const f32x4 x1 = acc[ai][bj][m][0], x2 = acc[ai][bj][m][1];
                    f32x4 o1 = x1, o2 = x2;
                    if (dorot) { o1 = (x1 * c4 - x2 * s4) * ksc; o2 = (x1 * s4 + x2 * c4) * ksc; }
                    u32x2 w1, w2; w1.x = cvt_pk_bf16(o1.x, o1.y); w1.y = cvt_pk_bf16(o1.z, o1.w); w2.x = cvt_pk_bf16(o2.x, o2.y); w2.y = cvt_pk_bf16(o2.z, o2.w);
                    bf16_t* p = H + (size_t)row * DIN + cb + bj * 128 + ((fq & 1) ? 60 : 0);
                    GST(u32x4, p) = widen16(w1, w2);
                }
            }
    }
};
template <bool RAW> struct EpiY {
    bf16_t* YH; bf16_t* YL; const float* res0; const float* res1; const f32x2* stats; const float* lw; const float* lb;
    __device__ __forceinline__ void operator()(f32x4 (&acc)[2][2][4][2], const pg8::Unit& u, int wr, int wc, int fr, int fq) const {
        asm volatile("" : "+v"(fr), "+v"(fq));
        const int rowt = u.pm * 256 + wr * 64 + fr, col0 = u.pn * 256 + wc * 32 + 4 * fq;
        const int colp = col0 + ((fq & 1) ? 12 : 0);
        const float* res = (u.pm >= S0 / 256) ? res1 - (size_t)S0 * DM : res0;
        f32x4 wv[2][2];
        if (!RAW) {
#pragma unroll
            for (int bj = 0; bj < 2; ++bj)
#pragma unroll
                for (int n = 0; n < 2; ++n) { wv[bj][n] = GLD(f32x4, lw + col0 + bj * 128 + n * 16); const f32x4 bv = GLD(f32x4, lb + col0 + bj * 128 + n * 16) * ALPHA;
#pragma unroll
                    for (int ai = 0; ai < 2; ++ai)
#pragma unroll
                        for (int m = 0; m < 4; ++m) acc[ai][bj][m][n] += bv; }
        }
#pragma unroll
        for (int ai = 0; ai < 2; ++ai)
#pragma unroll
          for (int mh = 0; mh < 2; ++mh) {
            f32x4 xr[2][2][2]; u32x4 ph[2][2], pl[2][2]; f32x2 st[2];
#pragma unroll
            for (int mm = 0; mm < 2; ++mm) { const int m = 2 * mh + mm; const size_t rb = (size_t)(rowt + ai * 128 + m * 16) * DM;
                if (!RAW) st[mm] = GLD(f32x2, stats + rowt + ai * 128 + m * 16);
#pragma unroll
                for (int bj = 0; bj < 2; ++bj) {
                    if (RAW) { xr[mm][bj][0] = GLD(f32x4, res + rb + col0 + bj * 128); xr[mm][bj][1] = GLD(f32x4, res + rb + col0 + bj * 128 + 16); }
                    else { ph[mm][bj] = GLD(u32x4, YH + rb + colp + bj * 128); pl[mm][bj] = GLD(u32x4, YL + rb + colp + bj * 128); } } }
#pragma unroll
            for (int mm = 0; mm < 2; ++mm) { const int m = 2 * mh + mm; const size_t rb = (size_t)(rowt + ai * 128 + m * 16) * DM;
                const float mu = RAW ? 0.f : st[mm].x, rs = RAW ? ALPHA : st[mm].y * ALPHA;
#pragma unroll
                for (int bj = 0; bj < 2; ++bj) {
                    f32x4 x0, x1;
                    if (RAW) { x0 = xr[mm][bj][0]; x1 = xr[mm][bj][1]; }
                    else { u32x2 h0, h1, l0, l1; unwiden16(ph[mm][bj], h0, h1); unwiden16(pl[mm][bj], l0, l1); x0 = hl_sum(h0, l0); x1 = hl_sum(h1, l1); }
                    f32x4 o0, o1;
                    if (RAW) { o0 = x0 * ALPHA + acc[ai][bj][m][0]; o1 = x1 * ALPHA + acc[ai][bj][m][1]; }
                    else { o0 = ((x0 - mu) * rs) * wv[bj][0] + acc[ai][bj][m][0]; o1 = ((x1 - mu) * rs) * wv[bj][1] + acc[ai][bj][m][1]; }
                    u32x2 a0, b0, a1, b1; hl_split(o0, a0, b0); hl_split(o1, a1, b1);
                    GST(u32x4, YH + rb + colp + bj * 128) = widen16(a0, a1); GST(u32x4, YL + rb + colp + bj * 128) = widen16(b0, b1); } }
            asm volatile("" ::: "memory");
          }
    }
};
struct EpiHid {
    bf16_t* HID;
    __device__ __forceinline__ void operator()(const f32x4 (&acc)[2][2][4][2], const pg8::Unit& u, int wr, int wc, int fr, int fq) const {
        asm volatile("" : "+v"(fr), "+v"(fq));
        const int rowt = u.pm * 256 + wr * 64 + fr, col0 = u.pn * 128 + wc * 32 + 8 * fq;
#pragma unroll
        for (int ai = 0; ai < 2; ++ai)
#pragma unroll
            for (int m = 0; m < 4; ++m) {
                const f32x4 g0 = acc[ai][0][m][0], g1 = acc[ai][0][m][1], u0 = acc[ai][1][m][0], u1 = acc[ai][1][m][1];
                u32x4 w;
                w.x = cvt_pk_bf16(silu_f(g0.x) * u0.x, silu_f(g0.y) * u0.y); w.y = cvt_pk_bf16(silu_f(g0.z) * u0.z, silu_f(g0.w) * u0.w);
                w.z = cvt_pk_bf16(silu_f(g1.x) * u1.x, silu_f(g1.y) * u1.y); w.w = cvt_pk_bf16(silu_f(g1.z) * u1.z, silu_f(g1.w) * u1.w);
                GST(u32x4, HID + (size_t)(rowt + ai * 128 + m * 16) * DFF + col0) = w;
            }
    }
};

__device__ __forceinline__ int rowmap(int kind, int c) {
    if (kind == 1) { const int o = c & 127, n = o >> 6, wc = (o & 63) >> 4, i = o & 15; return (c & ~127) + 32 * wc + 16 * n + i; }
    if (kind == 2) { const int up = c >= DFF ? 1 : 0, uu = up ? c - DFF : c, pn = uu >> 7, o = uu & 127, o32 = o & 31, a = o32 >> 3, n = (o32 >> 2) & 1, b = o32 & 3;
        return 256 * pn + 128 * up + (o & ~31) + 16 * n + 4 * a + b; }
    return c;
}
__device__ __forceinline__ void p0_transpose_item(const float* W, int K, int N, bf16_t* WT, int kind, LAS float* scr, int item, int lane) {
    const int nblk = N / 32, kb = item / nblk, nb = item % nblk, k0 = 64 * kb, n0 = 32 * nb;
    float wv[32];
    const float* wp = W + (size_t)(k0 + (lane >> 5)) * N + n0 + (lane & 31);
#pragma unroll
    for (int i = 0; i < 32; ++i) wv[i] = GLD(float, wp + (size_t)(2 * i) * N);
#pragma unroll
    for (int i = 0; i < 32; ++i) scr[(2 * i + (lane >> 5)) * 33 + (lane & 31)] = wv[i];
    LDS_WAIT();
    const int c = lane & 7;
#pragma unroll
    for (int j = 0; j < 4; ++j) { const int n = (lane >> 3) + 8 * j; const LAS float* s = scr + (8 * c) * 33 + n;
        u32x4 o; o.x = cvt_pk_bf16(s[0 * 33], s[1 * 33]); o.y = cvt_pk_bf16(s[2 * 33], s[3 * 33]); o.z = cvt_pk_bf16(s[4 * 33], s[5 * 33]); o.w = cvt_pk_bf16(s[6 * 33], s[7 * 33]);
        GST(u32x4, WT + (size_t)rowmap(kind, n0 + n) * K + k0 + 8 * c) = o; }
    LDS_WAIT();
}
__device__ __forceinline__ void sincos_d(double x, float& sn, float& cs) {
    const double n = rint(x * 0.63661977236758134308);
    double r = fma(-n, 1.57079632679489655800e+00, x); r = fma(-n, 6.12323399573676603587e-17, r);
    const double r2 = r * r;
    double sp = -7.6471637318198164759e-13; sp = fma(sp, r2, 1.6059043836821614599e-10); sp = fma(sp, r2, -2.5052108385441718775e-08); sp = fma(sp, r2, 2.7557319223985890653e-06);
    sp = fma(sp, r2, -1.9841269841269841270e-04); sp = fma(sp, r2, 8.3333333333333333333e-03); sp = fma(sp, r2, -1.6666666666666666667e-01);
    const double s = fma(r * r2, sp, r);
    double cp = 4.7794773323873852974e-14; cp = fma(cp, r2, -1.1470745597729724714e-11); cp = fma(cp, r2, 2.0876756987868098979e-09); cp = fma(cp, r2, -2.7557319223985890653e-07);
    cp = fma(cp, r2, 2.4801587301587301587e-05); cp = fma(cp, r2, -1.3888888888888888889e-03); cp = fma(cp, r2, 4.1666666666666666667e-02); cp = fma(cp, r2, -0.5);
    const double c = fma(r2, cp, 1.0);
    const int q = ((int)(long long)n) & 3;
    const double ss = (q & 1) ? c : s, cc = (q & 1) ? s : c;
    sn = (float)((q & 2) ? -ss : ss); cs = (float)(((q + 1) & 2) ? -cc : cc);
}

constexpr int TILE_BYTES = 32768;
__device__ __forceinline__ int toff(int row, int ch) { return 256 * row + 16 * (ch ^ (((row & 3) << 2) | ((row >> 2) & 3))); }
__device__ __forceinline__ void tile_fetch(u32x4 (&v)[4], const bf16_t* src, size_t ld, int tid) {
#pragma unroll
    for (int i = 0; i < 4; ++i) { const int id = tid + 512 * i, r = id >> 4, ch = id & 15; v[i] = GLD(u32x4, src + (size_t)r * ld + ch * 8); }
}
__device__ __forceinline__ void tile_put(LAS unsigned char* dst, const u32x4 (&v)[4], int tid) {
#pragma unroll
    for (int i = 0; i < 4; ++i) { const int id = tid + 512 * i, r = id >> 4, ch = id & 15; *(LAS u32x4*)(dst + toff(r, ch)) = v[i]; }
}
__device__ __forceinline__ void tile_put_scaled2(LAS unsigned char* dstF, LAS unsigned char* dstB, const u32x4 (&v)[4], float lgf2, float lgb2, int tid) {
#pragma unroll
    for (int i = 0; i < 4; ++i) { const int id = tid + 512 * i, r = id >> 4, ch = id & 15;
        const float zf = fast_exp2(lgf2 * (float)(127 - r)), zb = fast_exp2(lgb2 * (float)r);
        u32x4 of, ob;
#pragma unroll
        for (int w = 0; w < 4; ++w) { const float lo = bf_lo(v[i][w]), hi = bf_hi(v[i][w]); of[w] = cvt_pk_bf16(lo * zf, hi * zf); ob[w] = cvt_pk_bf16(lo * zb, hi * zb); }
        *(LAS u32x4*)(dstF + toff(r, ch)) = of; *(LAS u32x4*)(dstB + toff(r, ch)) = ob; }
}
struct LaneBases { int LN, TA, TB, PA; };
__device__ __forceinline__ LaneBases lane_bases(int lane) {
    const int fr = lane & 15, g = lane >> 4, q = fr >> 2, p = lane & 3, ph = p >> 1;
    LaneBases b;
    b.LN = 256 * fr + 16 * (g ^ (((fr & 3) << 2) | ((fr >> 2) & 3)));
    b.TA = 256 * (8 * g + q) + 16 * (ph ^ ((q << 2) | ((2 * g) & 3))) + 8 * (p & 1);
    b.TB = 256 * (8 * g + 4 + q) + 16 * (ph ^ ((q << 2) | ((2 * g + 1) & 3))) + 8 * (p & 1);
    b.PA = 256 * (4 * g + q) + 16 * (ph ^ ((q << 2) | (g & 3))) + 8 * (p & 1);
    return b;
}
__device__ __forceinline__ bf16x8 frag_n(LAS const unsigned char* t, int LN, int nt, int s) { return *(LAS const bf16x8*)(t + ((LN ^ (64 * s)) + 4096 * nt)); }
__device__ __forceinline__ bf16x8 frag_t(LAS const unsigned char* t, int La, int Lb, int offb, int xt, int s) {
    const s16x4 x = __builtin_amdgcn_ds_read_tr16_b64_v4i16((LAS s16x4*)(t + ((La ^ (32 * xt)) + 8192 * s)));
    const s16x4 y = __builtin_amdgcn_ds_read_tr16_b64_v4i16((LAS s16x4*)(t + ((Lb ^ (32 * xt)) + 8192 * s + offb)));
    return (bf16x8){x[0], x[1], x[2], x[3], y[0], y[1], y[2], y[3]};
}
#define FRAG_TS(T, xt, s) frag_t((T), LB_.TA, LB_.TB, 0, (xt), (s))
#define FRAG_TP(T, xt, s) frag_t((T), LB_.PA, LB_.PA, 4096, (xt), (s))
#define SCHED_FENCE __builtin_amdgcn_sched_barrier(0)
#define LANE_BASES LaneBases LB_ = lane_bases(lane); asm volatile("" : "+v"(LB_.LN), "+v"(LB_.TA), "+v"(LB_.TB), "+v"(LB_.PA)); \
    int fr_u = lane & 15, fg_u = lane >> 4, tid_u = tid_p; asm volatile("" : "+v"(fr_u), "+v"(fg_u), "+v"(tid_u)); const int fr = fr_u, fg = fg_u, tid = tid_u; (void)fr; (void)fg; (void)tid;
#define MFMA16(X, Y, ACC) __builtin_amdgcn_mfma_f32_16x16x32_bf16((X), (Y), (ACC), 0, 0, 0)


#define XB_TMO      128
#define XB_XCNT(j)  (256  + 64 * (j))
#define XB_XSUB(j)  (1280 + 64 * (j))
#define XB_XGEN(j)  (2304 + 64 * (j))
#define XB_TOP      3328
#define XB_TOPGEN   3392
#define XCD_BAR_WORDS 3456
#define XB_SPIN_CAP (1u << 22)
__device__ __forceinline__ unsigned xb_ld(unsigned* p)              { return __hip_atomic_load(p, __ATOMIC_RELAXED, __HIP_MEMORY_SCOPE_AGENT); }
__device__ __forceinline__ unsigned xb_add(unsigned* p, unsigned v) { return __hip_atomic_fetch_add(p, v, __ATOMIC_RELAXED, __HIP_MEMORY_SCOPE_AGENT); }
__device__ __forceinline__ unsigned xb_xcc_id() { return (unsigned)__builtin_amdgcn_s_getreg((3 << 11) | 20) & 0xFu; }
#define XB_SPIN(cond, bar) do { unsigned _sp = 0; while (cond) { __builtin_amdgcn_s_sleep(1); \
    if ((++_sp & 255u) == 0u) { if (xb_ld(&(bar)[XB_TMO])) break; if (_sp > XB_SPIN_CAP) { atomicAdd(&(bar)[XB_TMO], 1u); break; } } } } while (0)
__device__ __forceinline__ void xcd_barrier_complete(unsigned* bar, unsigned x, unsigned& nloc, unsigned& nx) {
    const unsigned G = gridDim.x * gridDim.y * gridDim.z;
    unsigned sum, cnt, mine, sp = 0u;
    for (;;) {
        sum = 0u; cnt = 0u; mine = 0u;
#pragma unroll
        for (unsigned j = 0; j < 16; ++j) { const unsigned c = xb_ld(&bar[XB_XCNT(j)]); sum += c; cnt += (c > 0u) ? 1u : 0u; mine = (j == x) ? c : mine; }
        if (sum == G) break;
        __builtin_amdgcn_s_sleep(1);
        if ((++sp & 255u) == 0u) { if (xb_ld(&bar[XB_TMO])) break; if (sp > XB_SPIN_CAP) { atomicAdd(&bar[XB_TMO], 1u); break; } }
    }
    nloc = mine > 0u ? mine : 1u; nx = cnt > 0u ? cnt : 1u;
}
__device__ __forceinline__ void xcd_barrier(unsigned* bar, volatile LAS unsigned* st) {
    asm volatile("s_waitcnt vmcnt(0)" ::: "memory");
    __syncthreads();
    if (threadIdx.x == 0) {
        const unsigned x = xb_xcc_id();
        __builtin_amdgcn_s_waitcnt(0);
        unsigned nloc = st[0], nx = st[1];
        if (nloc == 0u) { xcd_barrier_complete(bar, x, nloc, nx); st[0] = nloc; st[1] = nx; }
        const unsigned old = xb_add(&bar[XB_XSUB(x)], 1u);
        const unsigned gen = old / nloc;
        if (old + 1u == (gen + 1u) * nloc) {
            __builtin_amdgcn_fence(__ATOMIC_RELEASE, "agent");
            asm volatile("s_waitcnt vmcnt(0)" ::: "memory");
            const unsigned og = xb_add(&bar[XB_TOP], 1u);
            const unsigned tg = og / nx;
            if (og + 1u == (tg + 1u) * nx) xb_add(&bar[XB_TOPGEN], 1u);
            else XB_SPIN(xb_ld(&bar[XB_TOPGEN]) == tg, bar);
            __builtin_amdgcn_fence(__ATOMIC_ACQUIRE, "agent");
            xb_add(&bar[XB_XGEN(x)], 1u);
            asm volatile("s_waitcnt vmcnt(0)" ::: "memory");
        } else {
            XB_SPIN(xb_ld(&bar[XB_XGEN(x)]) == gen, bar);
            __builtin_amdgcn_fence(__ATOMIC_ACQUIRE, "agent");
            asm volatile("s_waitcnt vmcnt(0)" ::: "memory");
        }
    }
    __syncthreads();
}

struct Args {
    const float* x0; const float* x1; const float* w_in; const float* w_out; const float* dec_f; const float* dec_b; const float* gn_w; const float* sink; const float* rel_bias;
    const float* ln1_w; const float* ln1_b; const float* w_ffn_in; const float* w_ffn_out; const float* ln2_w; const float* ln2_b;
    float* out; unsigned char* ws; int ph_lo, ph_hi;
};

template <bool FINAL>
__device__ __forceinline__ void ln_phase(const bf16_t* YH, const bf16_t* YL, const float* w, const float* b, f32x2* stats, bf16_t* XN, float* out, int gw, int ngw, int lane) {
    f32x4 wv[8], bv[8];
#pragma unroll
    for (int j = 0; j < 4; ++j)
#pragma unroll
        for (int t = 0; t < 2; ++t) { wv[2 * j + t] = GLD(f32x4, (const f32x4*)w + 128 * j + 2 * lane + t); bv[2 * j + t] = GLD(f32x4, (const f32x4*)b + 128 * j + 2 * lane + t); }
    for (int row = gw; row < MTOK; row += ngw) {
        const size_t rb = (size_t)row * DM + 8 * lane;
        u32x4 hv[4], lv[4];
#pragma unroll
        for (int j = 0; j < 4; ++j) { hv[j] = GLD(u32x4, YH + rb + 512 * j); if (FINAL) lv[j] = GLD(u32x4, YL + rb + 512 * j); }
        f32x4 v[8]; float s = 0.f;
#pragma unroll
        for (int j = 0; j < 4; ++j) {
            v[2 * j] = (f32x4){bf_lo(hv[j].x), bf_hi(hv[j].x), bf_lo(hv[j].y), bf_hi(hv[j].y)}; v[2 * j + 1] = (f32x4){bf_lo(hv[j].z), bf_hi(hv[j].z), bf_lo(hv[j].w), bf_hi(hv[j].w)};
            if (FINAL) { v[2 * j] += (f32x4){bf_lo(lv[j].x), bf_hi(lv[j].x), bf_lo(lv[j].y), bf_hi(lv[j].y)}; v[2 * j + 1] += (f32x4){bf_lo(lv[j].z), bf_hi(lv[j].z), bf_lo(lv[j].w), bf_hi(lv[j].w)}; }
        }
#pragma unroll
        for (int j = 0; j < 8; ++j) s += (v[j].x + v[j].y) + (v[j].z + v[j].w);
#pragma unroll
        for (int o = 1; o < 64; o <<= 1) s += __shfl_xor(s, o);
        const float mean = s * (1.0f / DM); float q = 0.f;
#pragma unroll
        for (int j = 0; j < 8; ++j) { v[j] = v[j] - mean; q += (v[j].x * v[j].x + v[j].y * v[j].y) + (v[j].z * v[j].z + v[j].w * v[j].w); }
#pragma unroll
        for (int o = 1; o < 64; o <<= 1) q += __shfl_xor(q, o);
        const float rstd = 1.0f / sqrtf(q * (1.0f / DM) + 1e-5f);
        if (FINAL) {
#pragma unroll
            for (int j = 0; j < 4; ++j)
#pragma unroll
                for (int t = 0; t < 2; ++t) GST(f32x4, out + rb + 512 * j + 4 * t) = v[2 * j + t] * rstd * wv[2 * j + t] + bv[2 * j + t];
        } else {
            if (lane == 0) GST(f32x2, stats + row) = (f32x2){mean, rstd};
#pragma unroll
            for (int j = 0; j < 4; ++j) { const f32x4 o0 = v[2 * j] * rstd * wv[2 * j] + bv[2 * j], o1 = v[2 * j + 1] * rstd * wv[2 * j + 1] + bv[2 * j + 1];
                u32x4 p; p.x = cvt_pk_bf16(o0.x, o0.y); p.y = cvt_pk_bf16(o0.z, o0.w); p.z = cvt_pk_bf16(o1.x, o1.y); p.w = cvt_pk_bf16(o1.z, o1.w);
                GST(u32x4, XN + rb + 512 * j) = p; }
        }
    }
}

__device__ __forceinline__ bool phase_on(int p) { const Args* q = (const Args*)__builtin_amdgcn_kernarg_segment_ptr(); asm volatile("" : "+s"(q)); return p >= q->ph_lo && p < q->ph_hi; }

__global__ void __launch_bounds__(512, 2) mega_fwd(Args a_unused) {
    extern __shared__ __attribute__((aligned(16))) unsigned char lds_raw[];
    LAS unsigned char* lds = (LAS unsigned char*)lds_raw;
    cg::grid_group grid = cg::this_grid();
    (void)a_unused;
#define PHASE_VIEW \
    const Args* ap_ = (const Args*)__builtin_amdgcn_kernarg_segment_ptr(); asm volatile("" : "+s"(ap_)); const Args& a = *ap_; \
    int tid = threadIdx.x; asm volatile("" : "+v"(tid)); const int tid_p = tid; (void)tid_p; const int lane = tid & 63, wave = __builtin_amdgcn_readfirstlane(tid >> 6); \
    int G = gridDim.x, bid = blockIdx.x; asm volatile("" : "+s"(G), "+s"(bid)); const int fr = lane & 15, fg = lane >> 4, tq = (lane & 15) >> 2, tp = lane & 3; \
    unsigned char* ws = a.ws; bf16_t* XN = (bf16_t*)(ws + WS_XN); bf16_t* H = (bf16_t*)(ws + WS_H); bf16_t* HID = H; bf16_t* MIX = (bf16_t*)(ws + WS_MIX); \
    float* Y = a.out; bf16_t* YH = (bf16_t*)(ws + WS_YH); bf16_t* YL = (bf16_t*)(ws + WS_YL); (void)YH; (void)YL; bf16_t* KV = (bf16_t*)(ws + WS_Y); f32x2* STATS = (f32x2*)(ws + WS_STATS); float* LG = (float*)(ws + WS_LG); bf16_t* PREV = (bf16_t*)(ws + WS_PREV); float* ROT = (float*)(ws + WS_ROT); float* BIAS = (float*)(ws + WS_BIAS); \
    (void)STATS; (void)LG; (void)lane; (void)wave; (void)G; (void)bid; (void)fr; (void)fg; (void)tq; (void)tp; (void)XN; (void)H; (void)HID; (void)MIX; (void)Y; (void)KV; (void)PREV; (void)ROT; (void)BIAS;
    if (threadIdx.x < 2) ((volatile LAS unsigned*)(lds + 131072))[threadIdx.x] = 0u;
    { const Args* q0 = (const Args*)__builtin_amdgcn_kernarg_segment_ptr(); if (threadIdx.x == 0) (void)xb_add((unsigned*)(q0->ws + WS_BAR) + XB_XCNT(xb_xcc_id()), 1u); }
    __syncthreads();
    int ph = 0;
#define RUN_PHASE (phase_on(ph))
#define END_PHASE do { { const Args* q_ = (const Args*)__builtin_amdgcn_kernarg_segment_ptr(); asm volatile("" : "+s"(q_)); if (ph >= q_->ph_lo && ph + 1 < q_->ph_hi) { if (ph == 0) grid.sync(); else xcd_barrier((unsigned*)(q_->ws + WS_BAR), (volatile LAS unsigned*)(lds + 131072)); } } ++ph; } while (0)

    if (RUN_PHASE) { PHASE_VIEW
        LAS float* scr = (LAS float*)(lds + wave * 8448);
        const int gw = bid * 8 + wave, NGW = G * 8;
        constexpr int I_IN = (DM / 64) * (DIN / 32), I_OUT = (DM / 64) * (DM / 32), I_FI = (DM / 64) * (DFF2 / 32), I_FO = (DFF / 64) * (DM / 32), I_L = I_IN + I_OUT + I_FI + I_FO;
        for (int it = gw; it < DEPTH * I_L; it += NGW) {
            const int l = it / I_L; int r = it - l * I_L;
            if (r < I_IN) { p0_transpose_item(a.w_in + (size_t)l * DM * DIN, DM, DIN, (bf16_t*)(ws + WS_WIN + l * SZ_WIN), 1, scr, r, lane); continue; } r -= I_IN;
            if (r < I_OUT) { p0_transpose_item(a.w_out + (size_t)l * DM * DM, DM, DM, (bf16_t*)(ws + WS_WOUT + l * SZ_WOUT), 0, scr, r, lane); continue; } r -= I_OUT;
            if (r < I_FI) { p0_transpose_item(a.w_ffn_in + (size_t)l * DM * DFF2, DM, DFF2, (bf16_t*)(ws + WS_WFI + l * SZ_WFI), 2, scr, r, lane); continue; } r -= I_FI;
            p0_transpose_item(a.w_ffn_out + (size_t)l * DFF * DM, DFF, DM, (bf16_t*)(ws + WS_WFO + l * SZ_WFO), 0, scr, r, lane);
        }
        const size_t gt = (size_t)bid * 512 + tid, NT = (size_t)G * 512;
        for (size_t i = gt; i < (size_t)MTOK * DM / 4; i += NT) {
            const size_t n0 = (size_t)S0 * DM / 4;
            const f32x4 v = i < n0 ? GLD(f32x4, (const f32x4*)a.x0 + i) : GLD(f32x4, (const f32x4*)a.x1 + (i - n0));
            u32x2 p; p.x = cvt_pk_bf16(v.x, v.y); p.y = cvt_pk_bf16(v.z, v.w); GST(u32x2, (u32x2*)XN + i) = p;
        }
        for (size_t i = gt; i < (size_t)16384 * 64; i += NT) {
            const int pos = (int)(i >> 6), f = (int)(i & 63);
            const double inv = exp2(-(double)f * (13.287712379549449 / 64.0));
            float sn, cs; sincos_d((double)pos * inv, sn, cs);
            GST(f32x2, (f32x2*)ROT + i) = (f32x2){cs, sn};
        }
        if (gt < 8 * 257) {
            const int hq = (int)gt / 257, idx = (int)gt % 257, rel = idx - 128, n = rel < 0 ? -rel : rel;
            int bk = n < 8 ? n : (n < 12 ? 8 : n < 16 ? 9 : n < 23 ? 10 : n < 32 ? 11 : n < 46 ? 12 : n < 64 ? 13 : n < 91 ? 14 : 15);
            bk += rel > 0 ? 16 : 0;
            GST(float, BIAS + hq * 260 + idx) = GLD(float, a.rel_bias + bk * 8 + hq);
        }
        if (gt < DEPTH * 8 * 2) {
            const int dir = (int)gt & 1, lh = (int)gt >> 1;
            GST(float, LG + gt) = LOG2E * log_sigmoid_f(GLD(float, (dir ? a.dec_b : a.dec_f) + lh));
        }
    }
    END_PHASE;

#pragma unroll 1
    for (int l = 0; l < DEPTH; ++l) {
        if (RUN_PHASE) { PHASE_VIEW
            pg8::Gemm g{XN, (const bf16_t*)(ws + WS_WIN + l * SZ_WIN), MTOK, DIN, DM}; pg8::StaticOrder S; S.init(MTOK, DIN, G, bid);
            EpiH E{H, ROT};
            pg8::gemm_phase<EpiH>(lds, g, S, E, tid);
        }
        END_PHASE;

#pragma unroll 1
        for (int rep_ = 0; rep_ < MIX_REP; ++rep_) { if (rep_) { ph -= 3; grid.sync(); }
        if (RUN_PHASE) { PHASE_VIEW
            LAS unsigned char* B0 = lds; LAS unsigned char* B1 = lds + TILE_BYTES; LAS unsigned char* B2 = lds + 2 * TILE_BYTES;
            LAS float* btab = (LAS float*)(lds + 3 * TILE_BYTES);
#pragma unroll 1
            for (int u = bid; u < 2 * NCHUNK * 8; u += G) {
                if (u < NCHUNK * 8) {
                    LANE_BASES
                    const int jj = ((u & 255) >> 3) + 32 * (u >> 8);
                    const int b = (G == 256) ? 24 * (u & 7) + (jj >> 3) : (u >> 3), hq = (G == 256) ? (jj & 7) : (u & 7), kvh = hq >> 2, row0 = b * 128;
                    const int bi = b < 64 ? b : b - 64, nbk = b < 64 ? 64 : 128;
                    const bool v0 = bi > 0, v2 = bi < nbk - 1;
                    const float sink = GLD(float, a.sink + l * 8 + hq);
                    const bf16_t* kbase = H + (size_t)row0 * DIN + C_AK + kvh * 128;
                    const bf16_t* vbase = H + (size_t)row0 * DIN + C_AV + kvh * 128;
                    const int irow = 16 * wave + fr;
                    u32x4 t0[4], t1[4], t2[4];
                    tile_fetch(t0, v0 ? kbase - (size_t)128 * DIN : kbase, DIN, tid);
                    tile_fetch(t1, kbase, DIN, tid);
                    tile_fetch(t2, v2 ? kbase + (size_t)128 * DIN : kbase, DIN, tid);
                    bf16x8 qf[4];
#pragma unroll
                    for (int s = 0; s < 4; ++s) qf[s] = GLD(bf16x8, H + (size_t)(row0 + irow) * DIN + C_AQ + hq * 128 + 32 * s + 8 * fg);
                    const float bt = tid < 257 ? GLD(float, BIAS + hq * 260 + tid) : 0.f;
                    SCHED_FENCE;
                    __syncthreads();
                    tile_put(B0, t0, tid); tile_put(B1, t1, tid); tile_put(B2, t2, tid);
                    if (tid < 257) btab[tid] = bt;
                    tile_fetch(t0, v0 ? vbase - (size_t)128 * DIN : vbase, DIN, tid);
                    tile_fetch(t1, vbase, DIN, tid);
                    tile_fetch(t2, v2 ? vbase + (size_t)128 * DIN : vbase, DIN, tid);
                    SCHED_FENCE;
                    __syncthreads();
                    f32x4 sc[3][8];
#pragma unroll
                    for (int kb = 0; kb < 3; ++kb) {
                        const bool valid = kb == 0 ? v0 : (kb == 2 ? v2 : true);
                        LAS const unsigned char* T = lds + kb * TILE_BYTES;
#pragma unroll
                        for (int nt = 0; nt < 8; ++nt) {
                            sc[kb][nt] = (f32x4){0.f, 0.f, 0.f, 0.f};
                            if (!valid || (kb == 0 && nt < wave) || (kb == 2 && nt > wave)) continue;
                            bf16x8 kf[4];
#pragma unroll
                            for (int s = 0; s < 4; ++s) kf[s] = frag_n(T, LB_.LN, nt, s);
                            SCHED_FENCE;
#pragma unroll
                            for (int s = 0; s < 4; ++s) sc[kb][nt] = MFMA16(kf[s], qf[s], sc[kb][nt]);
                            SCHED_FENCE;
                        }
                    }
                    float mx = sink;
#pragma unroll
                    for (int kb = 0; kb < 3; ++kb) {
                        const bool valid = kb == 0 ? v0 : (kb == 2 ? v2 : true);
                        float bia[8][4];
#pragma unroll
                        for (int nt = 0; nt < 8; ++nt)
#pragma unroll
                            for (int r = 0; r < 4; ++r) {
                                const int rel = (kb - 1) * 128 + 16 * nt + 4 * fg + r - irow;
                                const bool ok = valid && rel >= -128 && rel <= 128;
                                bia[nt][r] = btab[ok ? rel + 128 : 0];
                            }
                        SCHED_FENCE;
#pragma unroll
                        for (int nt = 0; nt < 8; ++nt)
#pragma unroll
                            for (int r = 0; r < 4; ++r) {
                                const int rel = (kb - 1) * 128 + 16 * nt + 4 * fg + r - irow;
                                const bool ok = valid && rel >= -128 && rel <= 128;
                                const float sv = ok ? sc[kb][nt][r] * 0.08838834764831845f + bia[nt][r] : -1e30f;
                                sc[kb][nt][r] = sv; mx = fmaxf(mx, sv);
                            }
                        SCHED_FENCE;
                    }
                    mx = fmaxf(mx, __shfl_xor(mx, 16)); mx = fmaxf(mx, __shfl_xor(mx, 32));
                    float sum = 0.f;
                    bf16x8 pf[3][4];
#pragma unroll
                    for (int kb = 0; kb < 3; ++kb)
#pragma unroll
                        for (int s = 0; s < 4; ++s) {
                            float p[8];
#pragma unroll
                            for (int t = 0; t < 8; ++t) { const float sv = sc[kb][2 * s + (t >> 2)][t & 3]; p[t] = sv > -1e29f ? fast_exp2((sv - mx) * LOG2E) : 0.f; sum += p[t]; }
                            u32x4 w; w.x = cvt_pk_bf16(p[0], p[1]); w.y = cvt_pk_bf16(p[2], p[3]); w.z = cvt_pk_bf16(p[4], p[5]); w.w = cvt_pk_bf16(p[6], p[7]);
                            pf[kb][s] = __builtin_bit_cast(bf16x8, w);
                        }
                    sum += __shfl_xor(sum, 16); sum += __shfl_xor(sum, 32);
                    const float inv_den = 1.0f / (sum + fast_exp2((sink - mx) * LOG2E));
                    SCHED_FENCE;
                    __syncthreads();
                    tile_put(B0, t0, tid); tile_put(B1, t1, tid); tile_put(B2, t2, tid);
                    __syncthreads();
                    f32x4 oa[8];
#pragma unroll
                    for (int nt = 0; nt < 8; ++nt) oa[nt] = (f32x4){0.f, 0.f, 0.f, 0.f};
#pragma unroll
                    for (int kb = 0; kb < 3; ++kb) {
                        const bool valid = kb == 0 ? v0 : (kb == 2 ? v2 : true);
                        LAS const unsigned char* T = lds + kb * TILE_BYTES;
#pragma unroll
                        for (int s = 0; s < 4; ++s) {
                            if (!valid || (kb == 0 && 2 * s + 1 < wave) || (kb == 2 && 2 * s > wave)) continue;
                            bf16x8 vf[8];
#pragma unroll
                            for (int nt = 0; nt < 8; ++nt) vf[nt] = FRAG_TP(T, nt, s);
                            SCHED_FENCE;
#pragma unroll
                            for (int nt = 0; nt < 8; ++nt) oa[nt] = MFMA16(vf[nt], pf[kb][s], oa[nt]);
                            SCHED_FENCE;
                        }
                    }
                    bf16_t* orow = MIX + (size_t)(row0 + irow) * DM + 1024 + hq * 128 + 4 * fg;
#pragma unroll
                    for (int np = 0; np < 4; ++np) { u32x2 wa, wb;
                        wa.x = cvt_pk_bf16(oa[2 * np].x * inv_den, oa[2 * np].y * inv_den); wa.y = cvt_pk_bf16(oa[2 * np].z * inv_den, oa[2 * np].w * inv_den);
                        wb.x = cvt_pk_bf16(oa[2 * np + 1].x * inv_den, oa[2 * np + 1].y * inv_den); wb.y = cvt_pk_bf16(oa[2 * np + 1].z * inv_den, oa[2 * np + 1].w * inv_den);
                        GST(u32x4, orow + 32 * np + ((fg & 1) ? 12 : 0)) = widen16(wa, wb); }
                } else {
                    LANE_BASES
                    const int uu = u - NCHUNK * 8, c = uu >> 3, h = uu & 7, row0 = c * 128;
                    const float lgf2 = GLD(float, LG + (l * 8 + h) * 2), lgb2 = GLD(float, LG + (l * 8 + h) * 2 + 1);
                    u32x4 t0[4], t1[4];
                    tile_fetch(t0, H + (size_t)row0 * DIN + C_RK + h * 128, DIN, tid);
                    tile_fetch(t1, H + (size_t)row0 * DIN + C_RV + h * 128, DIN, tid);
                    SCHED_FENCE;
                    __syncthreads();
                    tile_put_scaled2(B0, B1, t0, lgf2, lgb2, tid);
                    tile_put(B2, t1, tid);
                    __syncthreads();
                    f32x4 af[8], ab[8];
#pragma unroll
                    for (int nt = 0; nt < 8; ++nt) { af[nt] = (f32x4){0.f, 0.f, 0.f, 0.f}; ab[nt] = (f32x4){0.f, 0.f, 0.f, 0.f}; }
#pragma unroll
                    for (int s = 0; s < 4; ++s) {
                        const bf16x8 kf = FRAG_TS(B0, wave, s);
                        const bf16x8 kb = FRAG_TS(B1, wave, s);
                        bf16x8 vf[8];
#pragma unroll
                        for (int nt = 0; nt < 8; ++nt) vf[nt] = FRAG_TS(B2, nt, s);
                        SCHED_FENCE;
#pragma unroll
                        for (int nt = 0; nt < 8; ++nt) { af[nt] = MFMA16(vf[nt], kf, af[nt]); ab[nt] = MFMA16(vf[nt], kb, ab[nt]); }
                        SCHED_FENCE;
                    }
                    bf16_t* kvf = KV + ((size_t)(c * 8 + h) * 2) * 16384 + (size_t)(16 * wave + fr) * 128 + 4 * fg;
#pragma unroll
                    for (int np = 0; np < 4; ++np) { u32x2 f0, f1, b0, b1;
                        f0.x = cvt_pk_bf16(af[2 * np].x, af[2 * np].y); f0.y = cvt_pk_bf16(af[2 * np].z, af[2 * np].w); f1.x = cvt_pk_bf16(af[2 * np + 1].x, af[2 * np + 1].y); f1.y = cvt_pk_bf16(af[2 * np + 1].z, af[2 * np + 1].w);
                        b0.x = cvt_pk_bf16(ab[2 * np].x, ab[2 * np].y); b0.y = cvt_pk_bf16(ab[2 * np].z, ab[2 * np].w); b1.x = cvt_pk_bf16(ab[2 * np + 1].x, ab[2 * np + 1].y); b1.y = cvt_pk_bf16(ab[2 * np + 1].z, ab[2 * np + 1].w);
                        const int so = 32 * np + ((fg & 1) ? 12 : 0);
                        GST(u32x4, kvf + so) = widen16(f0, f1); GST(u32x4, kvf + 16384 + so) = widen16(b0, b1); }
                }
            }
            __syncthreads();
        }
        END_PHASE;

        if (RUN_PHASE) { PHASE_VIEW
            for (int it = bid * 512 + tid; it < 2 * 8 * 2 * 4096; it += G * 512) {
                const int e4 = it & 4095, dir = (it >> 12) & 1, h = (it >> 13) & 7, seq = it >> 16;
                const float lg2 = GLD(float, LG + (l * 8 + h) * 2 + dir);
                const float gC = fast_exp2(lg2 * 128.0f);
                const int c0 = seq ? 64 : 0, nc = seq ? 128 : 64;
                const size_t cst = (size_t)8 * 2 * 16384;
                const size_t eo = ((size_t)h * 2 + dir) * 16384 + (size_t)e4 * 4;
                f32x4 st = {0.f, 0.f, 0.f, 0.f};
                for (int i0 = 0; i0 < nc; i0 += 8) {
                    f32x4 kv[8];
#pragma unroll
                    for (int j = 0; j < 8; ++j) { const int c = dir ? (c0 + nc - 1 - (i0 + j)) : (c0 + i0 + j); const u32x2 kw = GLD(u32x2, KV + c * cst + eo); kv[j] = (f32x4){bf_lo(kw.x), bf_hi(kw.x), bf_lo(kw.y), bf_hi(kw.y)}; }
#pragma unroll
                    for (int j = 0; j < 8; ++j) { const int c = dir ? (c0 + nc - 1 - (i0 + j)) : (c0 + i0 + j);
                        u32x2 w; w.x = cvt_pk_bf16(st.x, st.y); w.y = cvt_pk_bf16(st.z, st.w); GST(u32x2, PREV + c * cst + eo) = w;
                        st = st * gC + kv[j]; }
                }
            }
        }
        END_PHASE;

        if (RUN_PHASE) { PHASE_VIEW
            LAS unsigned char* B0 = lds; LAS unsigned char* B1 = lds + TILE_BYTES; LAS unsigned char* B2 = lds + 2 * TILE_BYTES; LAS unsigned char* B3 = lds + 3 * TILE_BYTES;
#pragma unroll 1
            for (int u = bid; u < NCHUNK * 8; u += G) {
                LANE_BASES
                const int c = u >> 3, h = u & 7, row0 = c * 128;
                const float lgf2 = GLD(float, LG + (l * 8 + h) * 2), lgb2 = GLD(float, LG + (l * 8 + h) * 2 + 1);
                const bf16_t* pv = PREV + ((size_t)(c * 8 + h) * 2) * 16384;
                const int irow = 16 * wave + fr;
                {
                    u32x4 t0[4], t1[4], t2[4], t3[4];
                    tile_fetch(t0, H + (size_t)row0 * DIN + C_RK + h * 128, DIN, tid);
                    tile_fetch(t1, H + (size_t)row0 * DIN + C_RV + h * 128, DIN, tid);
                    tile_fetch(t2, pv, 128, tid);
                    tile_fetch(t3, pv + 16384, 128, tid);
                    SCHED_FENCE;
                    __syncthreads();
                    tile_put(B0, t0, tid); tile_put(B1, t1, tid); tile_put(B2, t2, tid); tile_put(B3, t3, tid);
                }
                bf16x8 qf[4];
#pragma unroll
                for (int s = 0; s < 4; ++s) qf[s] = GLD(bf16x8, H + (size_t)(row0 + irow) * DIN + C_RQ + h * 128 + 32 * s + 8 * fg);
                SCHED_FENCE;
                __syncthreads();
                f32x4 sa[8], oa[8];
#pragma unroll
                for (int nt = 0; nt < 8; ++nt) { sa[nt] = (f32x4){0.f, 0.f, 0.f, 0.f}; oa[nt] = (f32x4){0.f, 0.f, 0.f, 0.f}; }
                bf16x8 fb[2][8];
#pragma unroll
                for (int nt = 0; nt < 8; ++nt) fb[0][nt] = frag_n(B0, LB_.LN, nt, 0);
#pragma unroll
                for (int s = 0; s < 4; ++s) {
#pragma unroll
                    for (int nt = 0; nt < 8; ++nt) fb[(s + 1) & 1][nt] = s < 3 ? frag_n(B0, LB_.LN, nt, s + 1) : FRAG_TP(B1, nt, 0);
                    SCHED_FENCE;
#pragma unroll
                    for (int nt = 0; nt < 8; ++nt) sa[nt] = MFMA16(fb[s & 1][nt], qf[s], sa[nt]);
                    SCHED_FENCE;
                }
                bf16x8 pf[4];
#pragma unroll
                for (int s = 0; s < 4; ++s) {
                    float p[8];
#pragma unroll
                    for (int t = 0; t < 8; ++t) { const int j = 32 * s + 16 * (t >> 2) + 4 * fg + (t & 3), df = irow - j;
                        const float dv = df >= 0 ? fast_exp2(lgf2 * (float)df) : fast_exp2(lgb2 * (float)(-df));
                        p[t] = sa[2 * s + (t >> 2)][t & 3] * dv; }
                    u32x4 w; w.x = cvt_pk_bf16(p[0], p[1]); w.y = cvt_pk_bf16(p[2], p[3]); w.z = cvt_pk_bf16(p[4], p[5]); w.w = cvt_pk_bf16(p[6], p[7]);
                    pf[s] = __builtin_bit_cast(bf16x8, w);
                }
#pragma unroll
                for (int s = 0; s < 4; ++s) {
#pragma unroll
                    for (int nt = 0; nt < 8; ++nt) fb[(s + 1) & 1][nt] = s < 3 ? FRAG_TP(B1, nt, s + 1) : FRAG_TS(B2, nt, 0);
                    SCHED_FENCE;
#pragma unroll
                    for (int nt = 0; nt < 8; ++nt) oa[nt] = MFMA16(fb[s & 1][nt], pf[s], oa[nt]);
                    SCHED_FENCE;
                }
                u32x2 gv[8];
                {
                    int ir_ = irow, fg_ = fg; asm volatile("" : "+v"(ir_), "+v"(fg_));
                    const bf16_t* grow = H + (size_t)(row0 + ir_) * DIN + C_RG + h * 128 + 4 * fg_;
#pragma unroll
                    for (int nt = 0; nt < 8; ++nt) gv[nt] = GLD(u32x2, grow + 16 * nt);
                }
                const float xif = fast_exp2(lgf2 * (float)(irow + 1)), xib = fast_exp2(lgb2 * (float)(128 - irow));
#pragma unroll
                for (int dir = 0; dir < 2; ++dir) {
                    LAS const unsigned char* T = dir ? B3 : B2;
#pragma unroll
                    for (int nt = 0; nt < 8; ++nt) sa[nt] = (f32x4){0.f, 0.f, 0.f, 0.f};
#pragma unroll
                    for (int s = 0; s < 4; ++s) {
                        if (s < 3 || dir == 0) {
#pragma unroll
                            for (int nt = 0; nt < 8; ++nt) fb[(s + 1) & 1][nt] = s < 3 ? FRAG_TS(T, nt, s + 1) : FRAG_TS(B3, nt, 0);
                        }
                        SCHED_FENCE;
#pragma unroll
                        for (int nt = 0; nt < 8; ++nt) sa[nt] = MFMA16(fb[s & 1][nt], qf[s], sa[nt]);
                        SCHED_FENCE;
                    }
                    const float xi = dir ? xib : xif;
#pragma unroll
                    for (int nt = 0; nt < 8; ++nt) oa[nt] += sa[nt] * xi;
                }
                f32x4 gwv[8];
                int ir2_ = irow, fg2_ = fg; asm volatile("" : "+v"(ir2_), "+v"(fg2_));
                {
                    const float* gw = a.gn_w + l * 1024 + h * 128 + 4 * fg2_;
#pragma unroll
                    for (int nt = 0; nt < 8; ++nt) gwv[nt] = GLD(f32x4, gw + 16 * nt);
                }
                float sm = 0.f;
#pragma unroll
                for (int nt = 0; nt < 8; ++nt) sm += (oa[nt].x + oa[nt].y) + (oa[nt].z + oa[nt].w);
                sm += __shfl_xor(sm, 16); sm += __shfl_xor(sm, 32);
                const float mu = sm * (1.0f / 128.0f); float qq = 0.f;
#pragma unroll
                for (int nt = 0; nt < 8; ++nt) { oa[nt] = oa[nt] - mu; qq += (oa[nt].x * oa[nt].x + oa[nt].y * oa[nt].y) + (oa[nt].z * oa[nt].z + oa[nt].w * oa[nt].w); }
                qq += __shfl_xor(qq, 16); qq += __shfl_xor(qq, 32);
                const float rstd = 1.0f / sqrtf(qq * (1.0f / 128.0f) + 1e-5f);
                bf16_t* orow = MIX + (size_t)(row0 + ir2_) * DM + h * 128 + 4 * fg2_;
#pragma unroll
                for (int np = 0; np < 4; ++np) {
                    u32x2 w[2];
#pragma unroll
                    for (int t = 0; t < 2; ++t) { const int nt = 2 * np + t; const f32x4 o = oa[nt] * rstd * gwv[nt];
                        w[t].x = cvt_pk_bf16(silu_f(bf_lo(gv[nt].x)) * o.x, silu_f(bf_hi(gv[nt].x)) * o.y); w[t].y = cvt_pk_bf16(silu_f(bf_lo(gv[nt].y)) * o.z, silu_f(bf_hi(gv[nt].y)) * o.w); }
                    GST(u32x4, orow + 32 * np + ((fg2_ & 1) ? 12 : 0)) = widen16(w[0], w[1]);
                }
            }
            __syncthreads();
        }
        END_PHASE;

        }
        if (RUN_PHASE) { PHASE_VIEW
            pg8::Gemm g{MIX, (const bf16_t*)(ws + WS_WOUT + l * SZ_WOUT), MTOK, DM, DM}; pg8::StaticOrder S; S.init(MTOK, DM, G, bid, 4);
            if (l == 0) { EpiY<true> E{YH, YL, a.x0, a.x1, STATS, a.ln2_w, a.ln2_b}; pg8::gemm_phase<EpiY<true>>(lds, g, S, E, tid); }
            else { EpiY<false> E{YH, YL, a.x0, a.x1, STATS, a.ln2_w + (l - 1) * DM, a.ln2_b + (l - 1) * DM}; pg8::gemm_phase<EpiY<false>>(lds, g, S, E, tid); }
        }
        END_PHASE;
        if (RUN_PHASE) { PHASE_VIEW ln_phase<false>(YH, YL, a.ln1_w + l * DM, a.ln1_b + l * DM, STATS, XN, Y, bid * 8 + wave, G * 8, lane); }
        END_PHASE;
        if (RUN_PHASE) { PHASE_VIEW
            pg8::Gemm g{XN, (const bf16_t*)(ws + WS_WFI + l * SZ_WFI), MTOK, DFF2, DM}; pg8::StaticOrder S; S.init(MTOK, DFF2, G, bid);
            EpiHid E{HID};
            pg8::gemm_phase<EpiHid>(lds, g, S, E, tid);
        }
        END_PHASE;
        if (RUN_PHASE) { PHASE_VIEW
            pg8::Gemm g{HID, (const bf16_t*)(ws + WS_WFO + l * SZ_WFO), MTOK, DM, DFF}; pg8::StaticOrder S; S.init(MTOK, DM, G, bid, 4);
            EpiY<false> E{YH, YL, a.x0, a.x1, STATS, a.ln1_w + l * DM, a.ln1_b + l * DM};
            pg8::gemm_phase<EpiY<false>>(lds, g, S, E, tid);
        }
        END_PHASE;
        if (RUN_PHASE) { PHASE_VIEW if (l == DEPTH - 1) ln_phase<true>(YH, YL, a.ln2_w + l * DM, a.ln2_b + l * DM, STATS, XN, Y, bid * 8 + wave, G * 8, lane);
            else ln_phase<false>(YH, YL, a.ln2_w + l * DM, a.ln2_b + l * DM, STATS, XN, Y, bid * 8 + wave, G * 8, lane); }
        END_PHASE;
    }
}

constexpr int N_PHASES = 1 + 9 * DEPTH;

extern "C" void kernel_launch(void* const* d_in, const int* in_sizes, int n_in, void* d_out, int out_size, void* d_ws, size_t ws_size, hipStream_t stream) {
    static int grid = 0;
    if (grid == 0) {
        if (n_in != 15 || ws_size < WS_END || out_size != MTOK * DM) { fprintf(stderr, "kernel_launch: unexpected shapes (n_in %d ws %zu need %zu out %d)\n", n_in, ws_size, (size_t)WS_END, out_size); grid = -1; return; }
        int dev = 0, cus = 0, per_cu = 0;
        hipGetDevice(&dev); hipDeviceGetAttribute(&cus, hipDeviceAttributeMultiprocessorCount, dev);
        if (hipFuncSetAttribute((const void*)mega_fwd, hipFuncAttributeMaxDynamicSharedMemorySize, LDS_BYTES) != hipSuccess) { fprintf(stderr, "kernel_launch: hipFuncSetAttribute failed\n"); grid = -1; return; }
        if (hipOccupancyMaxActiveBlocksPerMultiprocessor(&per_cu, (const void*)mega_fwd, 512, LDS_BYTES) != hipSuccess || per_cu < 1) { fprintf(stderr, "kernel_launch: occupancy query gave %d\n", per_cu); per_cu = 1; }
        (void)hipGetLastError();
        grid = cus * 1;
    }
    if (grid < 0) return;
    Args a{};
    a.x0 = (const float*)d_in[0]; a.x1 = (const float*)d_in[1]; a.w_in = (const float*)d_in[2]; a.w_out = (const float*)d_in[3]; a.dec_f = (const float*)d_in[4]; a.dec_b = (const float*)d_in[5];
    a.gn_w = (const float*)d_in[6]; a.sink = (const float*)d_in[7]; a.rel_bias = (const float*)d_in[8]; a.ln1_w = (const float*)d_in[9]; a.ln1_b = (const float*)d_in[10];
    a.w_ffn_in = (const float*)d_in[11]; a.w_ffn_out = (const float*)d_in[12]; a.ln2_w = (const float*)d_in[13]; a.ln2_b = (const float*)d_in[14];
    a.out = (float*)d_out; a.ws = (unsigned char*)d_ws;
#if ONE_LAUNCH
    a.ph_lo = 0; a.ph_hi = N_PHASES;
    if (hipMemsetAsync((unsigned char*)d_ws + WS_BAR, 0, 16384, stream) != hipSuccess) { fprintf(stderr, "kernel_launch: memset of the barrier words failed\n"); return; }
    void* args[] = {&a};
    hipError_t e = hipLaunchCooperativeKernel((const void*)mega_fwd, dim3(grid), dim3(512), args, LDS_BYTES, stream);
    if (e != hipSuccess) fprintf(stderr, "cooperative launch failed: %s (grid %d)\n", hipGetErrorString(e), grid);
#else
    for (int p = 0; p < N_PHASES; ++p) { a.ph_lo = p; a.ph_hi = p + 1; hipLaunchKernelGGL(mega_fwd, dim3(grid), dim3(512), LDS_BYTES, stream, a); }
#endif
}
```

```cpp
#include <hip/hip_runtime.h>
#include <hip/hip_cooperative_groups.h>
#include <cstdio>
#include <cstdint>
namespace cg = cooperative_groups;

#ifndef MIX_REP
#define MIX_REP 1
#endif
#ifndef ONE_LAUNCH
#define ONE_LAUNCH 1
#endif

#define LAS __attribute__((address_space(3)))
typedef unsigned short bf16_t;
typedef short bf16x8 __attribute__((ext_vector_type(8)));
typedef short s16x4 __attribute__((ext_vector_type(4)));
typedef float f32x4 __attribute__((ext_vector_type(4)));
typedef float f32x2 __attribute__((ext_vector_type(2)));
typedef unsigned u32x4 __attribute__((ext_vector_type(4)));
typedef unsigned u32x2 __attribute__((ext_vector_type(2)));

constexpr int S0 = 8192, S1 = 16384, MTOK = S0 + S1;
constexpr int DM = 2048, DIN = 5632, DFF = 5632, DFF2 = 11264, DEPTH = 4;
constexpr int C_RQ = 0, C_RK = 1024, C_RV = 2048, C_RG = 3072, C_AQ = 4096, C_AK = 5120, C_AV = 5376;
constexpr int NCHUNK = MTOK / 128;
constexpr float ALPHA = 1.681792830507429f;
constexpr float LOG2E = 1.4426950408889634f;

constexpr size_t SZ_WIN = (size_t)DIN * DM * 2, SZ_WOUT = (size_t)DM * DM * 2, SZ_WFI = (size_t)DFF2 * DM * 2, SZ_WFO = (size_t)DM * DFF * 2;
constexpr size_t WS_WIN = 0;
constexpr size_t WS_WOUT = WS_WIN + DEPTH * SZ_WIN;
constexpr size_t WS_WFI = WS_WOUT + DEPTH * SZ_WOUT;
constexpr size_t WS_WFO = WS_WFI + DEPTH * SZ_WFI;
constexpr size_t WS_XN = WS_WFO + DEPTH * SZ_WFO;
constexpr size_t WS_H = WS_XN + (size_t)MTOK * DM * 2;
constexpr size_t WS_MIX = WS_H + (size_t)MTOK * DIN * 2;
constexpr size_t WS_Y = WS_MIX + (size_t)MTOK * DM * 2;
constexpr size_t WS_YH = WS_Y + (size_t)MTOK * DM * 2;
constexpr size_t WS_PREV = WS_Y + (size_t)MTOK * DM * 4;
constexpr size_t WS_ROT = WS_PREV + (size_t)NCHUNK * 8 * 2 * 16384 * 2;
constexpr size_t WS_BIAS = WS_ROT + (size_t)16384 * 64 * 8;
constexpr size_t WS_LG = WS_BIAS + 12288;
constexpr size_t WS_STATS = WS_BIAS + 16384;
constexpr size_t WS_BAR = WS_STATS + (size_t)MTOK * 8;
constexpr size_t WS_YL = WS_BAR + 16384;
constexpr size_t WS_END = WS_YL + (size_t)MTOK * DM * 2;

constexpr int LDS_BYTES = 133120;

__device__ __forceinline__ unsigned cvt_pk_bf16(float lo, float hi) { unsigned r; asm volatile("v_cvt_pk_bf16_f32 %0, %1, %2" : "=v"(r) : "v"(lo), "v"(hi)); return r; }
__device__ __forceinline__ float bf_lo(unsigned w) { return __uint_as_float(w << 16); }
__device__ __forceinline__ float bf_hi(unsigned w) { return __uint_as_float(w & 0xffff0000u); }
__device__ __forceinline__ float fast_exp2(float x) { return __builtin_amdgcn_exp2f(x); }
__device__ __forceinline__ float fast_rcp(float x) { return __builtin_amdgcn_rcpf(x); }
__device__ __forceinline__ float silu_f(float g) { return g * fast_rcp(1.0f + fast_exp2(-g * LOG2E)); }
__device__ __forceinline__ float log_sigmoid_f(float x) { return x >= 0.f ? -log1pf(expf(-x)) : x - log1pf(expf(x)); }
#define LDS_WAIT() asm volatile("s_waitcnt lgkmcnt(0)" ::: "memory")
__device__ __forceinline__ u32x4 widen16(u32x2 a, u32x2 b) {
    const auto r0 = __builtin_amdgcn_permlane16_swap(a.x, b.x, false, false);
    const auto r1 = __builtin_amdgcn_permlane16_swap(a.y, b.y, false, false);
    u32x4 o; o.x = r0[0]; o.y = r1[0]; o.z = r0[1]; o.w = r1[1]; return o;
}
__device__ __forceinline__ void unwiden16(u32x4 v, u32x2& a, u32x2& b) {
    const auto r0 = __builtin_amdgcn_permlane16_swap(v.x, v.z, false, false);
    const auto r1 = __builtin_amdgcn_permlane16_swap(v.y, v.w, false, false);
    a.x = r0[0]; a.y = r1[0]; b.x = r0[1]; b.y = r1[1];
}
__device__ __forceinline__ f32x4 hl_sum(u32x2 h, u32x2 l) { return (f32x4){bf_lo(h.x) + bf_lo(l.x), bf_hi(h.x) + bf_hi(l.x), bf_lo(h.y) + bf_lo(l.y), bf_hi(h.y) + bf_hi(l.y)}; }
__device__ __forceinline__ void hl_split(f32x4 o, u32x2& h, u32x2& l) {
    h.x = cvt_pk_bf16(o.x, o.y); h.y = cvt_pk_bf16(o.z, o.w);
    l.x = cvt_pk_bf16(o.x - bf_lo(h.x), o.y - bf_hi(h.x)); l.y = cvt_pk_bf16(o.z - bf_lo(h.y), o.w - bf_hi(h.y));
}

#define GAS __attribute__((address_space(1)))
#define GLD(T, p) (*(const GAS T*)(p))
#define GST(T, p) (*(GAS T*)(p))

namespace pg8 {
constexpr int BM = 256, BK = 64, HALF = 128, HTB = HALF * BK * 2, STAGE_BYTES = 8 * HTB, NXCD = 8, WGM = 8;
__host__ __device__ __forceinline__ int lds_byte(int r, int c) { const int st = (r >> 4) * 2 + (c >> 5), rr = r & 15, cc = c & 31, ob = rr * 64 + cc * 2; return st * 1024 + (ob ^ (((ob >> 9) & 1) << 5)); }
__host__ __device__ __forceinline__ void stage_rc(int b, int& R, int& C) { const int st = b / 1024, sb = b % 1024, swz = sb ^ (((sb >> 9) & 1) << 5); R = (st >> 1) * 16 + swz / 64; C = (st & 1) * 32 + (swz % 64) / 2; }
struct Unit { int pm, pn; };
struct Gemm { const bf16_t* A; const bf16_t* Bt; int M, N, K; };
struct StaticOrder {
    int nM, nN, nwg, G, c, wgm;
    __device__ void init(int M, int N, int G_, int c_, int wgm_ = WGM) { nM = M / BM; nN = N / BM; nwg = nM * nN; G = G_; c = c_; wgm = wgm_; }
    __device__ bool next(int i, Unit& u) const {
        const long L = (long)i * G + c; if (L >= nwg) return false;
        int wgid = (int)L; { const int q = nwg / NXCD, r = nwg % NXCD, xcd = wgid % NXCD, off = wgid / NXCD; wgid = (xcd < r ? xcd * (q + 1) : r * (q + 1) + (xcd - r) * q) + off; }
        const int nig = wgm * nN, gid = wgid / nig, fm = gid * wgm, gsz = (nM - fm) < wgm ? (nM - fm) : wgm;
        u.pm = fm + ((wgid % nig) % gsz); u.pn = (wgid % nig) / gsz; return true;
    }
};

template <class Epi>
__device__ __forceinline__ void gemm_phase(LAS unsigned char* lds, const Gemm g, const StaticOrder& S, const Epi& E, const int tid) {
    const int wid = __builtin_amdgcn_readfirstlane(tid >> 6), lane = tid & 63, wr = wid >> 2, wc = wid & 3, fr = lane & 15, fq = lane >> 4;
    const int K = g.K, nt = K / BK;
    unsigned voffA[2];
#pragma unroll
    for (int i = 0; i < 2; ++i) { int R, C; stage_rc(tid * 16 + i * 8192, R, C); voffA[i] = (unsigned)(R * K + C) * 2u; }
    const size_t kstep = (size_t)(BK * 2);
    const size_t hstep = (size_t)HALF * K * 2;
    const size_t tstep = 2 * hstep;
    const unsigned ldsw = (unsigned)wid * 1024u;
    const int aoff = lds_byte(wr * 64 + fr, fq * 8), boff = lds_byte(wc * 32 + fr, fq * 8);
#define PG8_SA(b, h) (((b) * 2 + (h)) * HTB)
#define PG8_SB(b, h) ((4 + (b) * 2 + (h)) * HTB)
#define PG8_STAGE(bufoff, gbase) do { _Pragma("unroll") for (int _i = 0; _i < 2; ++_i) \
        __builtin_amdgcn_global_load_lds((const unsigned*)((const char*)(gbase) + voffA[_i]), (LAS unsigned*)(lds + (bufoff) + ldsw + _i * 8192), 16, 0, 0); } while (0)
#define PG8_LDA(dst, b, h) do { _Pragma("unroll") for (int m = 0; m < 4; ++m) _Pragma("unroll") for (int k = 0; k < 2; ++k) dst[m][k] = *(const LAS bf16x8*)(lds + PG8_SA(b, h) + aoff + m * 2048 + k * 1024); } while (0)
#define PG8_LDB(dst, b, h) do { _Pragma("unroll") for (int n = 0; n < 2; ++n) _Pragma("unroll") for (int k = 0; k < 2; ++k) dst[n][k] = *(const LAS bf16x8*)(lds + PG8_SB(b, h) + boff + n * 2048 + k * 1024); } while (0)
#define PG8_MMA(ai, bj, At, Bt) do { __builtin_amdgcn_s_setprio(1); _Pragma("unroll") for (int m = 0; m < 4; ++m) _Pragma("unroll") for (int n = 0; n < 2; ++n) _Pragma("unroll") for (int k = 0; k < 2; ++k) \
        acc[ai][bj][m][n] = __builtin_amdgcn_mfma_f32_16x16x32_bf16(Bt[n][k], At[m][k], acc[ai][bj][m][n], 0, 0, 0); __builtin_amdgcn_s_setprio(0); } while (0)
#define PG8_WAIT_V(n) asm volatile("s_waitcnt vmcnt(" #n ")" ::: "memory")
#define PG8_WAIT_L(n) asm volatile("s_waitcnt lgkmcnt(" #n ")" ::: "memory")
#define PG8_BAR __builtin_amdgcn_s_barrier()
#define PG8_SCHED __builtin_amdgcn_sched_barrier(0)
    Unit cur, nxt; int ui = 0;
    if (!S.next(0, cur)) return;
    f32x4 acc[2][2][4][2];
#pragma unroll
    for (int a = 0; a < 2; ++a)
#pragma unroll
        for (int b = 0; b < 2; ++b)
#pragma unroll
            for (int m = 0; m < 4; ++m)
#pragma unroll
                for (int n = 0; n < 2; ++n) acc[a][b][m][n] = (f32x4){0.f, 0.f, 0.f, 0.f};
    bf16x8 At[4][2], B0[2][2], B1[2][2];
    const char* cA = (const char*)g.A + (size_t)cur.pm * tstep; const char* cB = (const char*)g.Bt + (size_t)cur.pn * tstep;
    PG8_STAGE(PG8_SB(0, 0), cB); PG8_STAGE(PG8_SB(0, 1), cB + hstep); PG8_STAGE(PG8_SA(0, 0), cA); PG8_STAGE(PG8_SA(0, 1), cA + hstep);
    if (wr == 1) PG8_BAR;
    PG8_WAIT_V(2); PG8_BAR;
    PG8_STAGE(PG8_SB(1, 0), cB + kstep); PG8_STAGE(PG8_SA(1, 0), cA + kstep); PG8_STAGE(PG8_SB(1, 1), cB + hstep + kstep);
    PG8_WAIT_V(6); PG8_BAR;
    for (;;) {
        const bool has_next = S.next(ui + 1, nxt);
        const char* nA = has_next ? (const char*)g.A + (size_t)nxt.pm * tstep : cA; const char* nB = has_next ? (const char*)g.Bt + (size_t)nxt.pn * tstep : cB;
        for (int t = 0; t < nt; t += 2) {
            const bool last = (t == nt - 2);
            const char* a1 = cA + (size_t)(t + 1) * kstep;
            const char* a2 = last ? nA : cA + (size_t)(t + 2) * kstep; const char* b2 = last ? nB : cB + (size_t)(t + 2) * kstep;
            const char* a3 = a2 + kstep; const char* b3 = b2 + kstep;
            PG8_LDB(B0, 0, 0); PG8_LDB(B1, 0, 1); PG8_SCHED; PG8_LDA(At, 0, 0); PG8_STAGE(PG8_SA(1, 1), a1 + hstep);
            PG8_WAIT_V(8); PG8_WAIT_L(0); PG8_BAR; PG8_MMA(0, 0, At, B0); PG8_MMA(0, 1, At, B1); PG8_BAR; PG8_SCHED;
            PG8_LDA(At, 0, 1); PG8_STAGE(PG8_SB(0, 0), b2); PG8_STAGE(PG8_SB(0, 1), b2 + hstep); PG8_STAGE(PG8_SA(0, 0), a2);
            PG8_WAIT_V(8); PG8_WAIT_L(0); PG8_BAR; PG8_MMA(1, 0, At, B0); PG8_MMA(1, 1, At, B1); PG8_BAR; PG8_SCHED;
            PG8_LDB(B0, 1, 0); PG8_LDB(B1, 1, 1); PG8_SCHED; PG8_LDA(At, 1, 0); PG8_STAGE(PG8_SA(0, 1), a2 + hstep);
            PG8_WAIT_V(8); PG8_WAIT_L(0); PG8_BAR; PG8_MMA(0, 0, At, B0); PG8_MMA(0, 1, At, B1); PG8_BAR; PG8_SCHED;
            PG8_LDA(At, 1, 1); PG8_STAGE(PG8_SB(1, 0), b3); PG8_STAGE(PG8_SB(1, 1), b3 + hstep); PG8_STAGE(PG8_SA(1, 0), a3);
            PG8_WAIT_V(8); PG8_WAIT_L(0); PG8_BAR; PG8_MMA(1, 0, At, B0); PG8_MMA(1, 1, At, B1); PG8_BAR; PG8_SCHED;
        }
        if (wr == 0) PG8_BAR;
        E(acc, cur, wr, wc, fr, fq);
        if (!has_next) break;
#pragma unroll
        for (int a = 0; a < 2; ++a)
#pragma unroll
            for (int b = 0; b < 2; ++b)
#pragma unroll
                for (int m = 0; m < 4; ++m)
#pragma unroll
                    for (int n = 0; n < 2; ++n) acc[a][b][m][n] = (f32x4){0.f, 0.f, 0.f, 0.f};
        cur = nxt; cA = nA; cB = nB; ++ui;
        if (wr == 1) PG8_BAR;
    }
    PG8_WAIT_V(0);
    PG8_BAR;
#undef PG8_SA
#undef PG8_SB
#undef PG8_STAGE
#undef PG8_LDA
#undef PG8_LDB
#undef PG8_MMA
#undef PG8_WAIT_V
#undef PG8_WAIT_L
#undef PG8_BAR
#undef PG8_SCHED
}
}

struct EpiH {
    bf16_t* H; const float* rot;
    __device__ __forceinline__ void operator()(const f32x4 (&acc)[2][2][4][2], const pg8::Unit& u, int wr, int wc, int fr, int fq) const {
        asm volatile("" : "+v"(fr), "+v"(fq));
        const int rowt = u.pm * 256 + wr * 64 + fr;
        const int seq0 = (u.pm >= S0 / 256) ? S0 : 0;
        const bool dorot = u.pn < 8;
        const float ksc = (u.pn >= 4 && u.pn < 8) ? 0.08838834764831845f : 1.0f;
        const int cb = u.pn * 256 + 16 * wc + 4 * fq;
#pragma unroll
        for (int ai = 0; ai < 2; ++ai)
#pragma unroll
            for (int m = 0; m < 4; ++m) {
                const int row = rowt + ai * 128 + m * 16;
                f32x4 c4 = {1.f, 1.f, 1.f, 1.f}, s4 = {0.f, 0.f, 0.f, 0.f};
                if (dorot) { const GAS f32x4* rp = (const GAS f32x4*)(rot + ((size_t)(row - seq0) * 64 + 16 * wc + 4 * fq) * 2); const f32x4 a = rp[0], b = rp[1];
                    c4 = (f32x4){a.x, a.z, b.x, b.z}; s4 = (f32x4){a.y, a.w, b.y, b.w}; }
#pragma unroll
                for (int bj = 0; bj < 2; ++bj) {
                    const f32x4 x1 = acc[ai][bj][m][0], x2 = acc[ai][bj][m][1];
                    f32x4 o1 = x1, o2 = x2;
                    if (dorot) { o1 = (x1 * c4 - x2 * s4) * ksc; o2 = (x1 * s4 + x2 * c4) * ksc; }
                    u32x2 w1, w2; w1.x = cvt_pk_bf16(o1.x, o1.y); w1.y = cvt_pk_bf16(o1.z, o1.w); w2.x = cvt_pk_bf16(o2.x, o2.y); w2.y = cvt_pk_bf16(o2.z, o2.w);
                    bf16_t* p = H + (size_t)row * DIN + cb + bj * 128 + ((fq & 1) ? 60 : 0);
                    GST(u32x4, p) = widen16(w1, w2);
                }
            }
    }
};
template <bool RAW> struct EpiY {
    bf16_t* YH; bf16_t* YL; const float* res0; const float* res1; const f32x2* stats; const float* lw; const float* lb;
    __device__ __forceinline__ void operator()(f32x4 (&acc)[2][2][4][2], const pg8::Unit& u, int wr, int wc, int fr, int fq) const {
        asm volatile("" : "+v"(fr), "+v"(fq));
        const int rowt = u.pm * 256 + wr * 64 + fr, col0 = u.pn * 256 + wc * 32 + 4 * fq;
        const int colp = col0 + ((fq & 1) ? 12 : 0);
        const float* res = (u.pm >= S0 / 256) ? res1 - (size_t)S0 * DM : res0;
        f32x4 wv[2][2];
        if (!RAW) {
#pragma unroll
            for (int bj = 0; bj < 2; ++bj)
#pragma unroll
                for (int n = 0; n < 2; ++n) { wv[bj][n] = GLD(f32x4, lw + col0 + bj * 128 + n * 16); const f32x4 bv = GLD(f32x4, lb + col0 + bj * 128 + n * 16) * ALPHA;
#pragma unroll
                    for (int ai = 0; ai < 2; ++ai)
#pragma unroll
                        for (int m = 0; m < 4; ++m) acc[ai][bj][m][n] += bv; }
        }
#pragma unroll
        for (int ai = 0; ai < 2; ++ai)
#pragma unroll
          for (int mh = 0; mh < 2; ++mh) {
            f32x4 xr[2][2][2]; u32x4 ph[2][2], pl[2][2]; f32x2 st[2];
#pragma unroll
            for (int mm = 0; mm < 2; ++mm) { const int m = 2 * mh + mm; const size_t rb = (size_t)(rowt + ai * 128 + m * 16) * DM;
                if (!RAW) st[mm] = GLD(f32x2, stats + rowt + ai * 128 + m * 16);
#pragma unroll
                for (int bj = 0; bj < 2; ++bj) {
                    if (RAW) { xr[mm][bj][0] = GLD(f32x4, res + rb + col0 + bj * 128); xr[mm][bj][1] = GLD(f32x4, res + rb + col0 + bj * 128 + 16); }
                    else { ph[mm][bj] = GLD(u32x4, YH + rb + colp + bj * 128); pl[mm][bj] = GLD(u32x4, YL + rb + colp + bj * 128); } } }
#pragma unroll
            for (int mm = 0; mm < 2; ++mm) { const int m = 2 * mh + mm; const size_t rb = (size_t)(rowt + ai * 128 + m * 16) * DM;
                const float mu = RAW ? 0.f : st[mm].x, rs = RAW ? ALPHA : st[mm].y * ALPHA;
#pragma unroll
                for (int bj = 0; bj < 2; ++bj) {
                    f32x4 x0, x1;
                    if (RAW) { x0 = xr[mm][bj][0]; x1 = xr[mm][bj][1]; }
                    else { u32x2 h0, h1, l0, l1; unwiden16(ph[mm][bj], h0, h1); unwiden16(pl[mm][bj], l0, l1); x0 = hl_sum(h0, l0); x1 = hl_sum(h1, l1); }
                    f32x4 o0, o1;
                    if (RAW) { o0 = x0 * ALPHA + acc[ai][bj][m][0]; o1 = x1 * ALPHA + acc[ai][bj][m][1]; }
                    else { o0 = ((x0 - mu) * rs) * wv[bj][0] + acc[ai][bj][m][0]; o1 = ((x1 - mu) * rs) * wv[bj][1] + acc[ai][bj][m][1]; }
                    u32x2 a0, b0, a1, b1; hl_split(o0, a0, b0); hl_split(o1, a1, b1);
                    GST(u32x4, YH + rb + colp + bj * 128) = widen16(a0, a1); GST(u32x4, YL + rb + colp + bj * 128) = widen16(b0, b1); } }
            asm volatile("" ::: "memory");
          }
    }
};
struct EpiHid {
    bf16_t* HID;
    __device__ __forceinline__ void operator()(const f32x4 (&acc)[2][2][4][2], const pg8::Unit& u, int wr, int wc, int fr, int fq) const {
        asm volatile("" : "+v"(fr), "+v"(fq));
        const int rowt = u.pm * 256 + wr * 64 + fr, col0 = u.pn * 128 + wc * 32 + 8 * fq;
#pragma unroll
        for (int ai = 0; ai < 2; ++ai)
#pragma unroll
            for (int m = 0; m < 4; ++m) {
                const f32x4 g0 = acc[ai][0][m][0], g1 = acc[ai][0][m][1], u0 = acc[ai][1][m][0], u1 = acc[ai][1][m][1];
                u32x4 w;
                w.x = cvt_pk_bf16(silu_f(g0.x) * u0.x, silu_f(g0.y) * u0.y); w.y = cvt_pk_bf16(silu_f(g0.z) * u0.z, silu_f(g0.w) * u0.w);
                w.z = cvt_pk_bf16(silu_f(g1.x) * u1.x, silu_f(g1.y) * u1.y); w.w = cvt_pk_bf16(silu_f(g1.z) * u1.z, silu_f(g1.w) * u1.w);
                GST(u32x4, HID + (size_t)(rowt + ai * 128 + m * 16) * DFF + col0) = w;
            }
    }
};

__device__ __forceinline__ int rowmap(int kind, int c) {
    if (kind == 1) { const int o = c & 127, n = o >> 6, wc = (o & 63) >> 4, i = o & 15; return (c & ~127) + 32 * wc + 16 * n + i; }
    if (kind == 2) { const int up = c >= DFF ? 1 : 0, uu = up ? c - DFF : c, pn = uu >> 7, o = uu & 127, o32 = o & 31, a = o32 >> 3, n = (o32 >> 2) & 1, b = o32 & 3;
        return 256 * pn + 128 * up + (o & ~31) + 16 * n + 4 * a + b; }
    return c;
}
__device__ __forceinline__ void p0_transpose_item(const float* W, int K, int N, bf16_t* WT, int kind, LAS float* scr, int item, int lane) {
    const int nblk = N / 32, kb = item / nblk, nb = item % nblk, k0 = 64 * kb, n0 = 32 * nb;
    float wv[32];
    const float* wp = W + (size_t)(k0 + (lane >> 5)) * N + n0 + (lane & 31);
#pragma unroll
    for (int i = 0; i < 32; ++i) wv[i] = __builtin_nontemporal_load((const GAS float*)(wp + (size_t)(2 * i) * N));
#pragma unroll
    for (int i = 0; i < 32; ++i) scr[(2 * i + (lane >> 5)) * 33 + (lane & 31)] = wv[i];
    LDS_WAIT();
    const int c = lane & 7;
#pragma unroll
    for (int j = 0; j < 4; ++j) { const int n = (lane >> 3) + 8 * j; const LAS float* s = scr + (8 * c) * 33 + n;
        u32x4 o; o.x = cvt_pk_bf16(s[0 * 33], s[1 * 33]); o.y = cvt_pk_bf16(s[2 * 33], s[3 * 33]); o.z = cvt_pk_bf16(s[4 * 33], s[5 * 33]); o.w = cvt_pk_bf16(s[6 * 33], s[7 * 33]);
        GST(u32x4, WT + (size_t)rowmap(kind, n0 + n) * K + k0 + 8 * c) = o; }
    LDS_WAIT();
}
__device__ __forceinline__ void sincos_d(double x, float& sn, float& cs) {
    const double n = rint(x * 0.63661977236758134308);
    double r = fma(-n, 1.57079632679489655800e+00, x); r = fma(-n, 6.12323399573676603587e-17, r);
    const double r2 = r * r;
    double sp = -7.6471637318198164759e-13; sp = fma(sp, r2, 1.6059043836821614599e-10); sp = fma(sp, r2, -2.5052108385441718775e-08); sp = fma(sp, r2, 2.7557319223985890653e-06);
    sp = fma(sp, r2, -1.9841269841269841270e-04); sp = fma(sp, r2, 8.3333333333333333333e-03); sp = fma(sp, r2, -1.6666666666666666667e-01);
    const double s = fma(r * r2, sp, r);
    double cp = 4.7794773323873852974e-14; cp = fma(cp, r2, -1.1470745597729724714e-11); cp = fma(cp, r2, 2.0876756987868098979e-09); cp = fma(cp, r2, -2.7557319223985890653e-07);
    cp = fma(cp, r2, 2.4801587301587301587e-05); cp = fma(cp, r2, -1.3888888888888888889e-03); cp = fma(cp, r2, 4.1666666666666666667e-02); cp = fma(cp, r2, -0.5);
    const double c = fma(r2, cp, 1.0);
    const int q = ((int)(long long)n) & 3;
    const double ss = (q & 1) ? c : s, cc = (q & 1) ? s : c;
    sn = (float)((q & 2) ? -ss : ss); cs = (float)(((q + 1) & 2) ? -cc : cc);
}

constexpr int TILE_BYTES = 32768;
__device__ __forceinline__ int toff(int row, int ch) { return 256 * row + 16 * (ch ^ (((row & 3) << 2) | ((row >> 2) & 3))); }
__device__ __forceinline__ void tile_fetch(u32x4 (&v)[4], const bf16_t* src, size_t ld, int tid) {
#pragma unroll
    for (int i = 0; i < 4; ++i) { const int id = tid + 512 * i, r = id >> 4, ch = id & 15; v[i] = GLD(u32x4, src + (size_t)r * ld + ch * 8); }
}
__device__ __forceinline__ void tile_put(LAS unsigned char* dst, const u32x4 (&v)[4], int tid) {
#pragma unroll
    for (int i = 0; i < 4; ++i) { const int id = tid + 512 * i, r = id >> 4, ch = id & 15; *(LAS u32x4*)(dst + toff(r, ch)) = v[i]; }
}
__device__ __forceinline__ void tile_put_scaled2(LAS unsigned char* dstF, LAS unsigned char* dstB, const u32x4 (&v)[4], float lgf2, float lgb2, int tid) {
#pragma unroll
    for (int i = 0; i < 4; ++i) { const int id = tid + 512 * i, r = id >> 4, ch = id & 15;
        const float zf = fast_exp2(lgf2 * (float)(127 - r)), zb = fast_exp2(lgb2 * (float)r);
        u32x4 of, ob;
#pragma unroll
        for (int w = 0; w < 4; ++w) { const float lo = bf_lo(v[i][w]), hi = bf_hi(v[i][w]); of[w] = cvt_pk_bf16(lo * zf, hi * zf); ob[w] = cvt_pk_bf16(lo * zb, hi * zb); }
        *(LAS u32x4*)(dstF + toff(r, ch)) = of; *(LAS u32x4*)(dstB + toff(r, ch)) = ob; }
}
struct LaneBases { int LN, TA, TB, PA; };
__device__ __forceinline__ LaneBases lane_bases(int lane) {
    const int fr = lane & 15, g = lane >> 4, q = fr >> 2, p = lane & 3, ph = p >> 1;
    LaneBases b;
    b.LN = 256 * fr + 16 * (g ^ (((fr & 3) << 2) | ((fr >> 2) & 3)));
    b.TA = 256 * (8 * g + q) + 16 * (ph ^ ((q << 2) | ((2 * g) & 3))) + 8 * (p & 1);
    b.TB = 256 * (8 * g + 4 + q) + 16 * (ph ^ ((q << 2) | ((2 * g + 1) & 3))) + 8 * (p & 1);
    b.PA = 256 * (4 * g + q) + 16 * (ph ^ ((q << 2) | (g & 3))) + 8 * (p & 1);
    return b;
}
__device__ __forceinline__ bf16x8 frag_n(LAS const unsigned char* t, int LN, int nt, int s) { return *(LAS const bf16x8*)(t + ((LN ^ (64 * s)) + 4096 * nt)); }
__device__ __forceinline__ bf16x8 frag_t(LAS const unsigned char* t, int La, int Lb, int offb, int xt, int s) {
    const s16x4 x = __builtin_amdgcn_ds_read_tr16_b64_v4i16((LAS s16x4*)(t + ((La ^ (32 * xt)) + 8192 * s)));
    const s16x4 y = __builtin_amdgcn_ds_read_tr16_b64_v4i16((LAS s16x4*)(t + ((Lb ^ (32 * xt)) + 8192 * s + offb)));
    return (bf16x8){x[0], x[1], x[2], x[3], y[0], y[1], y[2], y[3]};
}
#define FRAG_TS(T, xt, s) frag_t((T), LB_.TA, LB_.TB, 0, (xt), (s))
#define FRAG_TP(T, xt, s) frag_t((T), LB_.PA, LB_.PA, 4096, (xt), (s))
#define SCHED_FENCE __builtin_amdgcn_sched_barrier(0)
#define LANE_BASES LaneBases LB_ = lane_bases(lane); asm volatile("" : "+v"(LB_.LN), "+v"(LB_.TA), "+v"(LB_.TB), "+v"(LB_.PA)); \
    int fr_u = lane & 15, fg_u = lane >> 4, tid_u = tid_p; asm volatile("" : "+v"(fr_u), "+v"(fg_u), "+v"(tid_u)); const int fr = fr_u, fg = fg_u, tid = tid_u; (void)fr; (void)fg; (void)tid;
#define MFMA16(X, Y, ACC) __builtin_amdgcn_mfma_f32_16x16x32_bf16((X), (Y), (ACC), 0, 0, 0)


#define XB_TMO      128
#define XB_XCNT(j)  (256  + 64 * (j))
#define XB_XSUB(j)  (1280 + 64 * (j))
#define XB_XGEN(j)  (2304 + 64 * (j))
#define XB_TOP      3328
#define XB_TOPGEN   3392
#define XCD_BAR_WORDS 3456
#define XB_SPIN_CAP (1u << 22)
__device__ __forceinline__ unsigned xb_ld(unsigned* p)              { return __hip_atomic_load(p, __ATOMIC_RELAXED, __HIP_MEMORY_SCOPE_AGENT); }
__device__ __forceinline__ unsigned xb_add(unsigned* p, unsigned v) { return __hip_atomic_fetch_add(p, v, __ATOMIC_RELAXED, __HIP_MEMORY_SCOPE_AGENT); }
__device__ __forceinline__ unsigned xb_xcc_id() { return (unsigned)__builtin_amdgcn_s_getreg((3 << 11) | 20) & 0xFu; }
#define XB_SPIN(cond, bar) do { unsigned _sp = 0; while (cond) { __builtin_amdgcn_s_sleep(1); \
    if ((++_sp & 255u) == 0u) { if (xb_ld(&(bar)[XB_TMO])) break; if (_sp > XB_SPIN_CAP) { atomicAdd(&(bar)[XB_TMO], 1u); break; } } } } while (0)
__device__ __forceinline__ void xcd_barrier_complete(unsigned* bar, unsigned x, unsigned& nloc, unsigned& nx) {
    const unsigned G = gridDim.x * gridDim.y * gridDim.z;
    unsigned sum, cnt, mine, sp = 0u;
    for (;;) {
        sum = 0u; cnt = 0u; mine = 0u;
#pragma unroll
        for (unsigned j = 0; j < 16; ++j) { const unsigned c = xb_ld(&bar[XB_XCNT(j)]); sum += c; cnt += (c > 0u) ? 1u : 0u; mine = (j == x) ? c : mine; }
        if (sum == G) break;
        __builtin_amdgcn_s_sleep(1);
        if ((++sp & 255u) == 0u) { if (xb_ld(&bar[XB_TMO])) break; if (sp > XB_SPIN_CAP) { atomicAdd(&bar[XB_TMO], 1u); break; } }
    }
    nloc = mine > 0u ? mine : 1u; nx = cnt > 0u ? cnt : 1u;
}
__device__ __forceinline__ void xcd_barrier(unsigned* bar, volatile LAS unsigned* st) {
    asm volatile("s_waitcnt vmcnt(0)" ::: "memory");
    __syncthreads();
    if (threadIdx.x == 0) {
        const unsigned x = xb_xcc_id();
        __builtin_amdgcn_s_waitcnt(0);
        unsigned nloc = st[0], nx = st[1];
        if (nloc == 0u) { xcd_barrier_complete(bar, x, nloc, nx); st[0] = nloc; st[1] = nx; }
        const unsigned old = xb_add(&bar[XB_XSUB(x)], 1u);
        const unsigned gen = old / nloc;
        if (old + 1u == (gen + 1u) * nloc) {
            __builtin_amdgcn_fence(__ATOMIC_RELEASE, "agent");
            asm volatile("s_waitcnt vmcnt(0)" ::: "memory");
            const unsigned og = xb_add(&bar[XB_TOP], 1u);
            const unsigned tg = og / nx;
            if (og + 1u == (tg + 1u) * nx) xb_add(&bar[XB_TOPGEN], 1u);
            else XB_SPIN(xb_ld(&bar[XB_TOPGEN]) == tg, bar);
            __builtin_amdgcn_fence(__ATOMIC_ACQUIRE, "agent");
            xb_add(&bar[XB_XGEN(x)], 1u);
            asm volatile("s_waitcnt vmcnt(0)" ::: "memory");
        } else {
            XB_SPIN(xb_ld(&bar[XB_XGEN(x)]) == gen, bar);
            __builtin_amdgcn_fence(__ATOMIC_ACQUIRE, "agent");
            asm volatile("s_waitcnt vmcnt(0)" ::: "memory");
        }
    }
    __syncthreads();
}

struct Args {
    const float* x0; const float* x1; const float* w_in; const float* w_out; const float* dec_f; const float* dec_b; const float* gn_w; const float* sink; const float* rel_bias;
    const float* ln1_w; const float* ln1_b; const float* w_ffn_in; const float* w_ffn_out; const float* ln2_w; const float* ln2_b;
    float* out; unsigned char* ws; int ph_lo, ph_hi;
};

template <bool FINAL>
__device__ __forceinline__ void ln_phase(const bf16_t* YH, const bf16_t* YL, const float* w, const float* b, f32x2* stats, bf16_t* XN, float* out, int gw, int ngw, int lane) {
    f32x4 wv[8], bv[8];
#pragma unroll
    for (int j = 0; j < 4; ++j)
#pragma unroll
        for (int t = 0; t < 2; ++t) { wv[2 * j + t] = GLD(f32x4, (const f32x4*)w + 128 * j + 2 * lane + t); bv[2 * j + t] = GLD(f32x4, (const f32x4*)b + 128 * j + 2 * lane + t); }
    for (int row = gw; row < MTOK; row += ngw) {
        const size_t rb = (size_t)row * DM + 8 * lane;
        u32x4 hv[4], lv[4];
#pragma unroll
        for (int j = 0; j < 4; ++j) { hv[j] = GLD(u32x4, YH + rb + 512 * j); if (FINAL) lv[j] = GLD(u32x4, YL + rb + 512 * j); }
        f32x4 v[8]; float s = 0.f;
#pragma unroll
        for (int j = 0; j < 4; ++j) {
            v[2 * j] = (f32x4){bf_lo(hv[j].x), bf_hi(hv[j].x), bf_lo(hv[j].y), bf_hi(hv[j].y)}; v[2 * j + 1] = (f32x4){bf_lo(hv[j].z), bf_hi(hv[j].z), bf_lo(hv[j].w), bf_hi(hv[j].w)};
            if (FINAL) { v[2 * j] += (f32x4){bf_lo(lv[j].x), bf_hi(lv[j].x), bf_lo(lv[j].y), bf_hi(lv[j].y)}; v[2 * j + 1] += (f32x4){bf_lo(lv[j].z), bf_hi(lv[j].z), bf_lo(lv[j].w), bf_hi(lv[j].w)}; }
        }
#pragma unroll
        for (int j = 0; j < 8; ++j) s += (v[j].x + v[j].y) + (v[j].z + v[j].w);
#pragma unroll
        for (int o = 1; o < 64; o <<= 1) s += __shfl_xor(s, o);
        const float mean = s * (1.0f / DM); float q = 0.f;
#pragma unroll
        for (int j = 0; j < 8; ++j) { v[j] = v[j] - mean; q += (v[j].x * v[j].x + v[j].y * v[j].y) + (v[j].z * v[j].z + v[j].w * v[j].w); }
#pragma unroll
        for (int o = 1; o < 64; o <<= 1) q += __shfl_xor(q, o);
        const float rstd = 1.0f / sqrtf(q * (1.0f / DM) + 1e-5f);
        if (FINAL) {
#pragma unroll
            for (int j = 0; j < 4; ++j)
#pragma unroll
                for (int t = 0; t < 2; ++t) GST(f32x4, out + rb + 512 * j + 4 * t) = v[2 * j + t] * rstd * wv[2 * j + t] + bv[2 * j + t];
        } else {
            if (lane == 0) GST(f32x2, stats + row) = (f32x2){mean, rstd};
#pragma unroll
            for (int j = 0; j < 4; ++j) { const f32x4 o0 = v[2 * j] * rstd * wv[2 * j] + bv[2 * j], o1 = v[2 * j + 1] * rstd * wv[2 * j + 1] + bv[2 * j + 1];
                u32x4 p; p.x = cvt_pk_bf16(o0.x, o0.y); p.y = cvt_pk_bf16(o0.z, o0.w); p.z = cvt_pk_bf16(o1.x, o1.y); p.w = cvt_pk_bf16(o1.z, o1.w);
                GST(u32x4, XN + rb + 512 * j) = p; }
        }
    }
}

__device__ __forceinline__ bool phase_on(int p) { const Args* q = (const Args*)__builtin_amdgcn_kernarg_segment_ptr(); asm volatile("" : "+s"(q)); return p >= q->ph_lo && p < q->ph_hi; }

__global__ void __launch_bounds__(512, 2) mega_fwd(Args a_unused) {
    extern __shared__ __attribute__((aligned(16))) unsigned char lds_raw[];
    LAS unsigned char* lds = (LAS unsigned char*)lds_raw;
    cg::grid_group grid = cg::this_grid();
    (void)a_unused;
#define PHASE_VIEW \
    const Args* ap_ = (const Args*)__builtin_amdgcn_kernarg_segment_ptr(); asm volatile("" : "+s"(ap_)); const Args& a = *ap_; \
    int tid = threadIdx.x; asm volatile("" : "+v"(tid)); const int tid_p = tid; (void)tid_p; const int lane = tid & 63, wave = __builtin_amdgcn_readfirstlane(tid >> 6); \
    int G = gridDim.x, bid = blockIdx.x; asm volatile("" : "+s"(G), "+s"(bid)); const int fr = lane & 15, fg = lane >> 4, tq = (lane & 15) >> 2, tp = lane & 3; \
    unsigned char* ws = a.ws; bf16_t* XN = (bf16_t*)(ws + WS_XN); bf16_t* H = (bf16_t*)(ws + WS_H); bf16_t* HID = H; bf16_t* MIX = (bf16_t*)(ws + WS_MIX); \
    float* Y = a.out; bf16_t* YH = (bf16_t*)(ws + WS_YH); bf16_t* YL = (bf16_t*)(ws + WS_YL); (void)YH; (void)YL; bf16_t* KV = (bf16_t*)(ws + WS_Y); f32x2* STATS = (f32x2*)(ws + WS_STATS); float* LG = (float*)(ws + WS_LG); bf16_t* PREV = (bf16_t*)(ws + WS_PREV); float* ROT = (float*)(ws + WS_ROT); float* BIAS = (float*)(ws + WS_BIAS); \
    (void)STATS; (void)LG; (void)lane; (void)wave; (void)G; (void)bid; (void)fr; (void)fg; (void)tq; (void)tp; (void)XN; (void)H; (void)HID; (void)MIX; (void)Y; (void)KV; (void)PREV; (void)ROT; (void)BIAS;
    if (threadIdx.x < 2) ((volatile LAS unsigned*)(lds + 131072))[threadIdx.x] = 0u;
    { const Args* q0 = (const Args*)__builtin_amdgcn_kernarg_segment_ptr(); if (threadIdx.x == 0) (void)xb_add((unsigned*)(q0->ws + WS_BAR) + XB_XCNT(xb_xcc_id()), 1u); }
    __syncthreads();
    int ph = 0;
#define RUN_PHASE (phase_on(ph))
#define END_PHASE do { { const Args* q_ = (const Args*)__builtin_amdgcn_kernarg_segment_ptr(); asm volatile("" : "+s"(q_)); if (ph >= q_->ph_lo && ph + 1 < q_->ph_hi) { if (ph == 0) grid.sync(); else xcd_barrier((unsigned*)(q_->ws + WS_BAR), (volatile LAS unsigned*)(lds + 131072)); } } ++ph; } while (0)

    if (RUN_PHASE) { PHASE_VIEW
        LAS float* scr = (LAS float*)(lds + wave * 8448);
        const int gw = bid * 8 + wave, NGW = G * 8;
        constexpr int I_IN = (DM / 64) * (DIN / 32), I_OUT = (DM / 64) * (DM / 32), I_FI = (DM / 64) * (DFF2 / 32), I_FO = (DFF / 64) * (DM / 32), I_L = I_IN + I_OUT + I_FI + I_FO;
        for (int it = gw; it < DEPTH * I_L; it += NGW) {
            const int l = it / I_L; int r = it - l * I_L;
            if (r < I_IN) { p0_transpose_item(a.w_in + (size_t)l * DM * DIN, DM, DIN, (bf16_t*)(ws + WS_WIN + l * SZ_WIN), 1, scr, r, lane); continue; } r -= I_IN;
            if (r < I_OUT) { p0_transpose_item(a.w_out + (size_t)l * DM * DM, DM, DM, (bf16_t*)(ws + WS_WOUT + l * SZ_WOUT), 0, scr, r, lane); continue; } r -= I_OUT;
            if (r < I_FI) { p0_transpose_item(a.w_ffn_in + (size_t)l * DM * DFF2, DM, DFF2, (bf16_t*)(ws + WS_WFI + l * SZ_WFI), 2, scr, r, lane); continue; } r -= I_FI;
            p0_transpose_item(a.w_ffn_out + (size_t)l * DFF * DM, DFF, DM, (bf16_t*)(ws + WS_WFO + l * SZ_WFO), 0, scr, r, lane);
        }
        const size_t gt = (size_t)bid * 512 + tid, NT = (size_t)G * 512;
        for (size_t i = gt; i < (size_t)MTOK * DM / 4; i += NT) {
            const size_t n0 = (size_t)S0 * DM / 4;
            const f32x4 v = i < n0 ? __builtin_nontemporal_load((const GAS f32x4*)a.x0 + i) : __builtin_nontemporal_load((const GAS f32x4*)a.x1 + (i - n0));
            u32x2 p; p.x = cvt_pk_bf16(v.x, v.y); p.y = cvt_pk_bf16(v.z, v.w); GST(u32x2, (u32x2*)XN + i) = p;
        }
        for (size_t i = gt; i < (size_t)16384 * 64; i += NT) {
            const int pos = (int)(i >> 6), f = (int)(i & 63);
            const double inv = exp2(-(double)f * (13.287712379549449 / 64.0));
            float sn, cs; sincos_d((double)pos * inv, sn, cs);
            GST(f32x2, (f32x2*)ROT + i) = (f32x2){cs, sn};
        }
        if (gt < 8 * 257) {
            const int hq = (int)gt / 257, idx = (int)gt % 257, rel = idx - 128, n = rel < 0 ? -rel : rel;
            int bk = n < 8 ? n : (n < 12 ? 8 : n < 16 ? 9 : n < 23 ? 10 : n < 32 ? 11 : n < 46 ? 12 : n < 64 ? 13 : n < 91 ? 14 : 15);
            bk += rel > 0 ? 16 : 0;
            GST(float, BIAS + hq * 260 + idx) = GLD(float, a.rel_bias + bk * 8 + hq);
        }
        if (gt < DEPTH * 8 * 2) {
            const int dir = (int)gt & 1, lh = (int)gt >> 1;
            GST(float, LG + gt) = LOG2E * log_sigmoid_f(GLD(float, (dir ? a.dec_b : a.dec_f) + lh));
        }
    }
    END_PHASE;

#pragma unroll 1
    for (int l = 0; l < DEPTH; ++l) {
        if (RUN_PHASE) { PHASE_VIEW
            pg8::Gemm g{XN, (const bf16_t*)(ws + WS_WIN + l * SZ_WIN), MTOK, DIN, DM}; pg8::StaticOrder S; S.init(MTOK, DIN, G, bid);
            EpiH E{H, ROT};
            pg8::gemm_phase<EpiH>(lds, g, S, E, tid);
        }
        END_PHASE;

#pragma unroll 1
        for (int rep_ = 0; rep_ < MIX_REP; ++rep_) { if (rep_) { ph -= 3; grid.sync(); }
        if (RUN_PHASE) { PHASE_VIEW
            LAS unsigned char* B0 = lds; LAS unsigned char* B1 = lds + TILE_BYTES; LAS unsigned char* B2 = lds + 2 * TILE_BYTES;
            LAS float* btab = (LAS float*)(lds + 3 * TILE_BYTES);
#pragma unroll 1
            for (int u = bid; u < 2 * NCHUNK * 8; u += G) {
                if (u < NCHUNK * 8) {
                    LANE_BASES
                    const int jj = ((u & 255) >> 3) + 32 * (u >> 8);
                    const int b = (G == 256) ? 24 * (u & 7) + (jj >> 3) : (u >> 3), hq = (G == 256) ? (jj & 7) : (u & 7), kvh = hq >> 2, row0 = b * 128;
                    const int bi = b < 64 ? b : b - 64, nbk = b < 64 ? 64 : 128;
                    const bool v0 = bi > 0, v2 = bi < nbk - 1;
                    const float sink = GLD(float, a.sink + l * 8 + hq);
                    const bf16_t* kbase = H + (size_t)row0 * DIN + C_AK + kvh * 128;
                    const bf16_t* vbase = H + (size_t)row0 * DIN + C_AV + kvh * 128;
                    const int irow = 16 * wave + fr;
                    u32x4 t0[4], t1[4], t2[4];
                    tile_fetch(t0, v0 ? kbase - (size_t)128 * DIN : kbase, DIN, tid);
                    tile_fetch(t1, kbase, DIN, tid);
                    tile_fetch(t2, v2 ? kbase + (size_t)128 * DIN : kbase, DIN, tid);
                    bf16x8 qf[4];
#pragma unroll
                    for (int s = 0; s < 4; ++s) qf[s] = GLD(bf16x8, H + (size_t)(row0 + irow) * DIN + C_AQ + hq * 128 + 32 * s + 8 * fg);
                    const float bt = tid < 257 ? GLD(float, BIAS + hq * 260 + tid) : 0.f;
                    SCHED_FENCE;
                    __syncthreads();
                    tile_put(B0, t0, tid); tile_put(B1, t1, tid); tile_put(B2, t2, tid);
                    if (tid < 257) btab[tid] = bt;
                    tile_fetch(t0, v0 ? vbase - (size_t)128 * DIN : vbase, DIN, tid);
                    tile_fetch(t1, vbase, DIN, tid);
                    tile_fetch(t2, v2 ? vbase + (size_t)128 * DIN : vbase, DIN, tid);
                    SCHED_FENCE;
                    __syncthreads();
                    f32x4 sc[3][8];
#pragma unroll
                    for (int kb = 0; kb < 3; ++kb) {
                        const bool valid = kb == 0 ? v0 : (kb == 2 ? v2 : true);
                        LAS const unsigned char* T = lds + kb * TILE_BYTES;
#pragma unroll
                        for (int nt = 0; nt < 8; ++nt) {
                            sc[kb][nt] = (f32x4){0.f, 0.f, 0.f, 0.f};
                            if (!valid || (kb == 0 && nt < wave) || (kb == 2 && nt > wave)) continue;
                            bf16x8 kf[4];
#pragma unroll
                            for (int s = 0; s < 4; ++s) kf[s] = frag_n(T, LB_.LN, nt, s);
                            SCHED_FENCE;
#pragma unroll
                            for (int s = 0; s < 4; ++s) sc[kb][nt] = MFMA16(kf[s], qf[s], sc[kb][nt]);
                            SCHED_FENCE;
                        }
                    }
                    float mx = sink;
#pragma unroll
                    for (int kb = 0; kb < 3; ++kb) {
                        const bool valid = kb == 0 ? v0 : (kb == 2 ? v2 : true);
                        float bia[8][4];
#pragma unroll
                        for (int nt = 0; nt < 8; ++nt)
#pragma unroll
                            for (int r = 0; r < 4; ++r) {
                                const int rel = (kb - 1) * 128 + 16 * nt + 4 * fg + r - irow;
                                const bool ok = valid && rel >= -128 && rel <= 128;
                                bia[nt][r] = btab[ok ? rel + 128 : 0];
                            }
                        SCHED_FENCE;
#pragma unroll
                        for (int nt = 0; nt < 8; ++nt)
#pragma unroll
                            for (int r = 0; r < 4; ++r) {
                                const int rel = (kb - 1) * 128 + 16 * nt + 4 * fg + r - irow;
                                const bool ok = valid && rel >= -128 && rel <= 128;
                                const float sv = ok ? sc[kb][nt][r] * 0.08838834764831845f + bia[nt][r] : -1e30f;
                                sc[kb][nt][r] = sv; mx = fmaxf(mx, sv);
                            }
                        SCHED_FENCE;
                    }
                    mx = fmaxf(mx, __shfl_xor(mx, 16)); mx = fmaxf(mx, __shfl_xor(mx, 32));
                    float sum = 0.f;
                    bf16x8 pf[3][4];
#pragma unroll
                    for (int kb = 0; kb < 3; ++kb)
#pragma unroll
                        for (int s = 0; s < 4; ++s) {
                            float p[8];
#pragma unroll
                            for (int t = 0; t < 8; ++t) { const float sv = sc[kb][2 * s + (t >> 2)][t & 3]; p[t] = sv > -1e29f ? fast_exp2((sv - mx) * LOG2E) : 0.f; sum += p[t]; }
                            u32x4 w; w.x = cvt_pk_bf16(p[0], p[1]); w.y = cvt_pk_bf16(p[2], p[3]); w.z = cvt_pk_bf16(p[4], p[5]); w.w = cvt_pk_bf16(p[6], p[7]);
                            pf[kb][s] = __builtin_bit_cast(bf16x8, w);
                        }
                    sum += __shfl_xor(sum, 16); sum += __shfl_xor(sum, 32);
                    const float inv_den = 1.0f / (sum + fast_exp2((sink - mx) * LOG2E));
                    SCHED_FENCE;
                    __syncthreads();
                    tile_put(B0, t0, tid); tile_put(B1, t1, tid); tile_put(B2, t2, tid);
                    __syncthreads();
                    f32x4 oa[8];
#pragma unroll
                    for (int nt = 0; nt < 8; ++nt) oa[nt] = (f32x4){0.f, 0.f, 0.f, 0.f};
#pragma unroll
                    for (int kb = 0; kb < 3; ++kb) {
                        const bool valid = kb == 0 ? v0 : (kb == 2 ? v2 : true);
                        LAS const unsigned char* T = lds + kb * TILE_BYTES;
#pragma unroll
                        for (int s = 0; s < 4; ++s) {
                            if (!valid || (kb == 0 && 2 * s + 1 < wave) || (kb == 2 && 2 * s > wave)) continue;
                            bf16x8 vf[8];
#pragma unroll
                            for (int nt = 0; nt < 8; ++nt) vf[nt] = FRAG_TP(T, nt, s);
                            SCHED_FENCE;
#pragma unroll
                            for (int nt = 0; nt < 8; ++nt) oa[nt] = MFMA16(vf[nt], pf[kb][s], oa[nt]);
                            SCHED_FENCE;
                        }
                    }
                    bf16_t* orow = MIX + (size_t)(row0 + irow) * DM + 1024 + hq * 128 + 4 * fg;
#pragma unroll
                    for (int np = 0; np < 4; ++np) { u32x2 wa, wb;
                        wa.x = cvt_pk_bf16(oa[2 * np].x * inv_den, oa[2 * np].y * inv_den); wa.y = cvt_pk_bf16(oa[2 * np].z * inv_den, oa[2 * np].w * inv_den);
                        wb.x = cvt_pk_bf16(oa[2 * np + 1].x * inv_den, oa[2 * np + 1].y * inv_den); wb.y = cvt_pk_bf16(oa[2 * np + 1].z * inv_den, oa[2 * np + 1].w * inv_den);
                        GST(u32x4, orow + 32 * np + ((fg & 1) ? 12 : 0)) = widen16(wa, wb); }
                } else {
                    LANE_BASES
                    const int uu = u - NCHUNK * 8, c = uu >> 3, h = uu & 7, row0 = c * 128;
                    const float lgf2 = GLD(float, LG + (l * 8 + h) * 2), lgb2 = GLD(float, LG + (l * 8 + h) * 2 + 1);
                    u32x4 t0[4], t1[4];
                    tile_fetch(t0, H + (size_t)row0 * DIN + C_RK + h * 128, DIN, tid);
                    tile_fetch(t1, H + (size_t)row0 * DIN + C_RV + h * 128, DIN, tid);
                    SCHED_FENCE;
                    __syncthreads();
                    tile_put_scaled2(B0, B1, t0, lgf2, lgb2, tid);
                    tile_put(B2, t1, tid);
                    __syncthreads();
                    f32x4 af[8], ab[8];
#pragma unroll
                    for (int nt = 0; nt < 8; ++nt) { af[nt] = (f32x4){0.f, 0.f, 0.f, 0.f}; ab[nt] = (f32x4){0.f, 0.f, 0.f, 0.f}; }
#pragma unroll
                    for (int s = 0; s < 4; ++s) {
                        const bf16x8 kf = FRAG_TS(B0, wave, s);
                        const bf16x8 kb = FRAG_TS(B1, wave, s);
                        bf16x8 vf[8];
#pragma unroll
                        for (int nt = 0; nt < 8; ++nt) vf[nt] = FRAG_TS(B2, nt, s);
                        SCHED_FENCE;
#pragma unroll
                        for (int nt = 0; nt < 8; ++nt) { af[nt] = MFMA16(vf[nt], kf, af[nt]); ab[nt] = MFMA16(vf[nt], kb, ab[nt]); }
                        SCHED_FENCE;
                    }
                    bf16_t* kvf = KV + ((size_t)(c * 8 + h) * 2) * 16384 + (size_t)(16 * wave + fr) * 128 + 4 * fg;
#pragma unroll
                    for (int np = 0; np < 4; ++np) { u32x2 f0, f1, b0, b1;
                        f0.x = cvt_pk_bf16(af[2 * np].x, af[2 * np].y); f0.y = cvt_pk_bf16(af[2 * np].z, af[2 * np].w); f1.x = cvt_pk_bf16(af[2 * np + 1].x, af[2 * np + 1].y); f1.y = cvt_pk_bf16(af[2 * np + 1].z, af[2 * np + 1].w);
                        b0.x = cvt_pk_bf16(ab[2 * np].x, ab[2 * np].y); b0.y = cvt_pk_bf16(ab[2 * np].z, ab[2 * np].w); b1.x = cvt_pk_bf16(ab[2 * np + 1].x, ab[2 * np + 1].y); b1.y = cvt_pk_bf16(ab[2 * np + 1].z, ab[2 * np + 1].w);
                        const int so = 32 * np + ((fg & 1) ? 12 : 0);
                        GST(u32x4, kvf + so) = widen16(f0, f1); GST(u32x4, kvf + 16384 + so) = widen16(b0, b1); }
                }
            }
            __syncthreads();
        }
        END_PHASE;

        if (RUN_PHASE) { PHASE_VIEW
            for (int it = bid * 512 + tid; it < 2 * 8 * 2 * 4096; it += G * 512) {
                const int e4 = it & 4095, dir = (it >> 12) & 1, h = (it >> 13) & 7, seq = it >> 16;
                const float lg2 = GLD(float, LG + (l * 8 + h) * 2 + dir);
                const float gC = fast_exp2(lg2 * 128.0f);
                const int c0 = seq ? 64 : 0, nc = seq ? 128 : 64;
                const size_t cst = (size_t)8 * 2 * 16384;
                const size_t eo = ((size_t)h * 2 + dir) * 16384 + (size_t)e4 * 4;
                f32x4 st = {0.f, 0.f, 0.f, 0.f};
                for (int i0 = 0; i0 < nc; i0 += 8) {
                    f32x4 kv[8];
#pragma unroll
                    for (int j = 0; j < 8; ++j) { const int c = dir ? (c0 + nc - 1 - (i0 + j)) : (c0 + i0 + j); const u32x2 kw = GLD(u32x2, KV + c * cst + eo); kv[j] = (f32x4){bf_lo(kw.x), bf_hi(kw.x), bf_lo(kw.y), bf_hi(kw.y)}; }
#pragma unroll
                    for (int j = 0; j < 8; ++j) { const int c = dir ? (c0 + nc - 1 - (i0 + j)) : (c0 + i0 + j);
                        u32x2 w; w.x = cvt_pk_bf16(st.x, st.y); w.y = cvt_pk_bf16(st.z, st.w); GST(u32x2, PREV + c * cst + eo) = w;
                        st = st * gC + kv[j]; }
                }
            }
        }
        END_PHASE;

        if (RUN_PHASE) { PHASE_VIEW
            LAS unsigned char* B0 = lds; LAS unsigned char* B1 = lds + TILE_BYTES; LAS unsigned char* B2 = lds + 2 * TILE_BYTES; LAS unsigned char* B3 = lds + 3 * TILE_BYTES;
#pragma unroll 1
            for (int u = bid; u < NCHUNK * 8; u += G) {
                LANE_BASES
                const int c = u >> 3, h = u & 7, row0 = c * 128;
                const float lgf2 = GLD(float, LG + (l * 8 + h) * 2), lgb2 = GLD(float, LG + (l * 8 + h) * 2 + 1);
                const bf16_t* pv = PREV + ((size_t)(c * 8 + h) * 2) * 16384;
                const int irow = 16 * wave + fr;
                {
                    u32x4 t0[4], t1[4], t2[4], t3[4];
                    tile_fetch(t0, H + (size_t)row0 * DIN + C_RK + h * 128, DIN, tid);
                    tile_fetch(t1, H + (size_t)row0 * DIN + C_RV + h * 128, DIN, tid);
                    tile_fetch(t2, pv, 128, tid);
                    tile_fetch(t3, pv + 16384, 128, tid);
                    SCHED_FENCE;
                    __syncthreads();
                    tile_put(B0, t0, tid); tile_put(B1, t1, tid); tile_put(B2, t2, tid); tile_put(B3, t3, tid);
                }
                bf16x8 qf[4];
#pragma unroll
                for (int s = 0; s < 4; ++s) qf[s] = GLD(bf16x8, H + (size_t)(row0 + irow) * DIN + C_RQ + h * 128 + 32 * s + 8 * fg);
                SCHED_FENCE;
                __syncthreads();
                f32x4 sa[8], oa[8];
#pragma unroll
                for (int nt = 0; nt < 8; ++nt) { sa[nt] = (f32x4){0.f, 0.f, 0.f, 0.f}; oa[nt] = (f32x4){0.f, 0.f, 0.f, 0.f}; }
                bf16x8 fb[2][8];
#pragma unroll
                for (int nt = 0; nt < 8; ++nt) fb[0][nt] = frag_n(B0, LB_.LN, nt, 0);
#pragma unroll
                for (int s = 0; s < 4; ++s) {
#pragma unroll
                    for (int nt = 0; nt < 8; ++nt) fb[(s + 1) & 1][nt] = s < 3 ? frag_n(B0, LB_.LN, nt, s + 1) : FRAG_TP(B1, nt, 0);
                    SCHED_FENCE;
#pragma unroll
                    for (int nt = 0; nt < 8; ++nt) sa[nt] = MFMA16(fb[s & 1][nt], qf[s], sa[nt]);
                    SCHED_FENCE;
                }
                bf16x8 pf[4];
#pragma unroll
                for (int s = 0; s < 4; ++s) {
                    float p[8];
#pragma unroll
                    for (int t = 0; t < 8; ++t) { const int j = 32 * s + 16 * (t >> 2) + 4 * fg + (t & 3), df = irow - j;
                        const float dv = df >= 0 ? fast_exp2(lgf2 * (float)df) : fast_exp2(lgb2 * (float)(-df));
                        p[t] = sa[2 * s + (t >> 2)][t & 3] * dv; }
                    u32x4 w; w.x = cvt_pk_bf16(p[0], p[1]); w.y = cvt_pk_bf16(p[2], p[3]); w.z = cvt_pk_bf16(p[4], p[5]); w.w = cvt_pk_bf16(p[6], p[7]);
                    pf[s] = __builtin_bit_cast(bf16x8, w);
                }
#pragma unroll
                for (int s = 0; s < 4; ++s) {
#pragma unroll
                    for (int nt = 0; nt < 8; ++nt) fb[(s + 1) & 1][nt] = s < 3 ? FRAG_TP(B1, nt, s + 1) : FRAG_TS(B2, nt, 0);
                    SCHED_FENCE;
#pragma unroll
                    for (int nt = 0; nt < 8; ++nt) oa[nt] = MFMA16(fb[s & 1][nt], pf[s], oa[nt]);
                    SCHED_FENCE;
                }
                u32x2 gv[8];
                {
                    int ir_ = irow, fg_ = fg; asm volatile("" : "+v"(ir_), "+v"(fg_));
                    const bf16_t* grow = H + (size_t)(row0 + ir_) * DIN + C_RG + h * 128 + 4 * fg_;
#pragma unroll
                    for (int nt = 0; nt < 8; ++nt) gv[nt] = GLD(u32x2, grow + 16 * nt);
                }
                const float xif = fast_exp2(lgf2 * (float)(irow + 1)), xib = fast_exp2(lgb2 * (float)(128 - irow));
#pragma unroll
                for (int dir = 0; dir < 2; ++dir) {
                    LAS const unsigned char* T = dir ? B3 : B2;
#pragma unroll
                    for (int nt = 0; nt < 8; ++nt) sa[nt] = (f32x4){0.f, 0.f, 0.f, 0.f};
#pragma unroll
                    for (int s = 0; s < 4; ++s) {
                        if (s < 3 || dir == 0) {
#pragma unroll
                            for (int nt = 0; nt < 8; ++nt) fb[(s + 1) & 1][nt] = s < 3 ? FRAG_TS(T, nt, s + 1) : FRAG_TS(B3, nt, 0);
                        }
                        SCHED_FENCE;
#pragma unroll
                        for (int nt = 0; nt < 8; ++nt) sa[nt] = MFMA16(fb[s & 1][nt], qf[s], sa[nt]);
                        SCHED_FENCE;
                    }
                    const float xi = dir ? xib : xif;
#pragma unroll
                    for (int nt = 0; nt < 8; ++nt) oa[nt] += sa[nt] * xi;
                }
                f32x4 gwv[8];
                int ir2_ = irow, fg2_ = fg; asm volatile("" : "+v"(ir2_), "+v"(fg2_));
                {
                    const float* gw = a.gn_w + l * 1024 + h * 128 + 4 * fg2_;
#pragma unroll
                    for (int nt = 0; nt < 8; ++nt) gwv[nt] = GLD(f32x4, gw + 16 * nt);
                }
                float sm = 0.f;
#pragma unroll
                for (int nt = 0; nt < 8; ++nt) sm += (oa[nt].x + oa[nt].y) + (oa[nt].z + oa[nt].w);
                sm += __shfl_xor(sm, 16); sm += __shfl_xor(sm, 32);
                const float mu = sm * (1.0f / 128.0f); float qq = 0.f;
#pragma unroll
                for (int nt = 0; nt < 8; ++nt) { oa[nt] = oa[nt] - mu; qq += (oa[nt].x * oa[nt].x + oa[nt].y * oa[nt].y) + (oa[nt].z * oa[nt].z + oa[nt].w * oa[nt].w); }
                qq += __shfl_xor(qq, 16); qq += __shfl_xor(qq, 32);
                const float rstd = 1.0f / sqrtf(qq * (1.0f / 128.0f) + 1e-5f);
                bf16_t* orow = MIX + (size_t)(row0 + ir2_) * DM + h * 128 + 4 * fg2_;
#pragma unroll
                for (int np = 0; np < 4; ++np) {
                    u32x2 w[2];
#pragma unroll
                    for (int t = 0; t < 2; ++t) { const int nt = 2 * np + t; const f32x4 o = oa[nt] * rstd * gwv[nt];
                        w[t].x = cvt_pk_bf16(silu_f(bf_lo(gv[nt].x)) * o.x, silu_f(bf_hi(gv[nt].x)) * o.y); w[t].y = cvt_pk_bf16(silu_f(bf_lo(gv[nt].y)) * o.z, silu_f(bf_hi(gv[nt].y)) * o.w); }
                    GST(u32x4, orow + 32 * np + ((fg2_ & 1) ? 12 : 0)) = widen16(w[0], w[1]);
                }
            }
            __syncthreads();
        }
        END_PHASE;

        }
        if (RUN_PHASE) { PHASE_VIEW
            pg8::Gemm g{MIX, (const bf16_t*)(ws + WS_WOUT + l * SZ_WOUT), MTOK, DM, DM}; pg8::StaticOrder S; S.init(MTOK, DM, G, bid, 4);
            if (l == 0) { EpiY<true> E{YH, YL, a.x0, a.x1, STATS, a.ln2_w, a.ln2_b}; pg8::gemm_phase<EpiY<true>>(lds, g, S, E, tid); }
            else { EpiY<false> E{YH, YL, a.x0, a.x1, STATS, a.ln2_w + (l - 1) * DM, a.ln2_b + (l - 1) * DM}; pg8::gemm_phase<EpiY<false>>(lds, g, S, E, tid); }
        }
        END_PHASE;
        if (RUN_PHASE) { PHASE_VIEW ln_phase<false>(YH, YL, a.ln1_w + l * DM, a.ln1_b + l * DM, STATS, XN, Y, bid * 8 + wave, G * 8, lane); }
        END_PHASE;
        if (RUN_PHASE) { PHASE_VIEW
            pg8::Gemm g{XN, (const bf16_t*)(ws + WS_WFI + l * SZ_WFI), MTOK, DFF2, DM}; pg8::StaticOrder S; S.init(MTOK, DFF2, G, bid);
            EpiHid E{HID};
            pg8::gemm_phase<EpiHid>(lds, g, S, E, tid);
        }
        END_PHASE;
        if (RUN_PHASE) { PHASE_VIEW
            pg8::Gemm g{HID, (const bf16_t*)(ws + WS_WFO + l * SZ_WFO), MTOK, DM, DFF}; pg8::StaticOrder S; S.init(MTOK, DM, G, bid, 4);
            EpiY<false> E{YH, YL, a.x0, a.x1, STATS, a.ln1_w + l * DM, a.ln1_b + l * DM};
            pg8::gemm_phase<EpiY<false>>(lds, g, S, E, tid);
        }
        END_PHASE;
        if (RUN_PHASE) { PHASE_VIEW if (l == DEPTH - 1) ln_phase<true>(YH, YL, a.ln2_w + l * DM, a.ln2_b + l * DM, STATS, XN, Y, bid * 8 + wave, G * 8, lane);
            else ln_phase<false>(YH, YL, a.ln2_w + l * DM, a.ln2_b + l * DM, STATS, XN, Y, bid * 8 + wave, G * 8, lane); }
        END_PHASE;
    }
}

constexpr int N_PHASES = 1 + 9 * DEPTH;

extern "C" void kernel_launch(void* const* d_in, const int* in_sizes, int n_in, void* d_out, int out_size, void* d_ws, size_t ws_size, hipStream_t stream) {
    static int grid = 0;
    if (grid == 0) {
        if (n_in != 15 || ws_size < WS_END || out_size != MTOK * DM) { fprintf(stderr, "kernel_launch: unexpected shapes (n_in %d ws %zu need %zu out %d)\n", n_in, ws_size, (size_t)WS_END, out_size); grid = -1; return; }
        int dev = 0, cus = 0, per_cu = 0;
        hipGetDevice(&dev); hipDeviceGetAttribute(&cus, hipDeviceAttributeMultiprocessorCount, dev);
        if (hipFuncSetAttribute((const void*)mega_fwd, hipFuncAttributeMaxDynamicSharedMemorySize, LDS_BYTES) != hipSuccess) { fprintf(stderr, "kernel_launch: hipFuncSetAttribute failed\n"); grid = -1; return; }
        if (hipOccupancyMaxActiveBlocksPerMultiprocessor(&per_cu, (const void*)mega_fwd, 512, LDS_BYTES) != hipSuccess || per_cu < 1) { fprintf(stderr, "kernel_launch: occupancy query gave %d\n", per_cu); per_cu = 1; }
        (void)hipGetLastError();
        grid = cus * 1;
    }
    if (grid < 0) return;
    Args a{};
    a.x0 = (const float*)d_in[0]; a.x1 = (const float*)d_in[1]; a.w_in = (const float*)d_in[2]; a.w_out = (const float*)d_in[3]; a.dec_f = (const float*)d_in[4]; a.dec_b = (const float*)d_in[5];
    a.gn_w = (const float*)d_in[6]; a.sink = (const float*)d_in[7]; a.rel_bias = (const float*)d_in[8]; a.ln1_w = (const float*)d_in[9]; a.ln1_b = (const float*)d_in[10];
    a.w_ffn_in = (const float*)d_in[11]; a.w_ffn_out = (const float*)d_in[12]; a.ln2_w = (const float*)d_in[13]; a.ln2_b = (const float*)d_in[14];
    a.out = (float*)d_out; a.ws = (unsigned char*)d_ws;
#if ONE_LAUNCH
    a.ph_lo = 0; a.ph_hi = N_PHASES;
    if (hipMemsetAsync((unsigned char*)d_ws + WS_BAR, 0, 16384, stream) != hipSuccess) { fprintf(stderr, "kernel_launch: memset of the barrier words failed\n"); return; }
    void* args[] = {&a};
    hipError_t e = hipLaunchCooperativeKernel((const void*)mega_fwd, dim3(grid), dim3(512), args, LDS_BYTES, stream);
    if (e != hipSuccess) fprintf(stderr, "cooperative launch failed: %s (grid %d)\n", hipGetErrorString(e), grid);
#else
    for (int p = 0; p < N_PHASES; ++p) { a.ph_lo = p; a.ph_hi = p + 1; hipLaunchKernelGGL(mega_fwd, dim3(grid), dim3(512), LDS_BYTES, stream, a); }
#endif
}
```
